# Optimizing an MI355X kernel written in HIP

```python
import math
import jax, jax.numpy as jnp
from jax import lax
import numpy as np

D_MODEL = 1024
BATCH = 8
SEQ = 2048
DEPTH = 4
DEC_BATCH = 32
DEC_SEQ = 16
PAST_LEN = 4096

CHUNK = 64
N_A_LAYERS = DEPTH // 2
N_B_LAYERS = DEPTH - N_A_LAYERS
SSM_EXPAND = 2
SSM_INNER = SSM_EXPAND * D_MODEL
SSM_HEAD_DIM = 64
SSM_HEADS = SSM_INNER // SSM_HEAD_DIM
SSM_STATE = 128
SSM_GROUPS = 8
SSM_HEADS_PER_GROUP = SSM_HEADS // SSM_GROUPS
CONV_WIDTH = 4
CONV_DIM = SSM_INNER + 2 * SSM_GROUPS * SSM_STATE
SSM_IN_DIM = SSM_INNER + CONV_DIM + SSM_HEADS
WINDOW = 128
WIN_CHUNKS = WINDOW // CHUNK
ATTN_HEADS = 16
KV_HEADS = 4
ATTN_HEAD_DIM = 64
Q_PER_KV = ATTN_HEADS // KV_HEADS
KV_DIM = KV_HEADS * ATTN_HEAD_DIM
PEER_HEADS = 8
PEER_NKEYS = 128
PEER_EXPERTS = PEER_NKEYS * PEER_NKEYS
PEER_QDIM = 256
PEER_HALF = PEER_QDIM // 2
PEER_TOPK = 16
PEER_TOKEN_BLOCK = 128
EPS = 1e-6

kernel_name = 'yoco_ssd_swa_sink_peer_stream_step'


def rmsnorm(x, g):
    xf = x.astype(jnp.float32)
    y = xf * lax.rsqrt(jnp.mean(xf * xf, axis=-1, keepdims=True) + EPS)
    return (y * g.astype(jnp.float32)).astype(x.dtype)


def causal_conv(xbc, prev, w, b):
    L = xbc.shape[1]
    xp = jnp.concatenate([prev.astype(xbc.dtype), xbc], axis=1)
    out = b
    for k in range(CONV_WIDTH):
        out = out + xp[:, k:k + L] * w[k]
    return jax.nn.silu(out), xp[:, -(CONV_WIDTH - 1):]


def ssd_scan(x, dt, A, B, C, s0, block):
    f32 = jnp.float32
    bsz, L = x.shape[:2]
    nc, Q, G, R = L // block, block, SSM_GROUPS, SSM_HEADS_PER_GROUP
    x = x.astype(f32).reshape(bsz, nc, Q, G, R, SSM_HEAD_DIM)
    dt = dt.astype(f32).reshape(bsz, nc, Q, G, R)
    B = B.astype(f32).reshape(bsz, nc, Q, G, SSM_STATE)
    C = C.astype(f32).reshape(bsz, nc, Q, G, SSM_STATE)
    s0 = s0.astype(f32).reshape(bsz, G, R, SSM_HEAD_DIM, SSM_STATE)
    acum = jnp.cumsum(dt * A.reshape(G, R), axis=2)
    seg = acum[:, :, :, None] - acum[:, :, None, :]
    causal = jnp.tril(jnp.ones((Q, Q), bool))[:, :, None, None]
    lmat = jnp.exp(jnp.where(causal, seg, -jnp.inf))
    xdt = x * dt[..., None]
    cb = jnp.einsum('bcign,bcjgn->bcijg', C, B)
    y_diag = jnp.einsum('bcijgr,bcjgrp->bcigrp', cb[..., None] * lmat, xdt)
    decay_end = jnp.exp(acum[:, :, -1:] - acum)
    states = jnp.einsum('bcjgn,bcjgrp->bcgrpn', B, xdt * decay_end[..., None])
    chunk_decay = jnp.exp(acum[:, :, -1])

    def step(s, inp):
        dec, st = inp
        return dec[..., None, None] * s + st, s

    s_fin, s_prev = lax.scan(step, s0, (jnp.moveaxis(chunk_decay, 1, 0), jnp.moveaxis(states, 1, 0)))
    s_prev = jnp.moveaxis(s_prev, 0, 1)
    y_off = jnp.einsum('bcign,bcgrpn->bcigrp', C, s_prev) * jnp.exp(acum)[..., None]
    y = (y_diag + y_off).reshape(bsz, L, SSM_HEADS, SSM_HEAD_DIM)
    return y, s_fin.reshape(bsz, SSM_HEADS, SSM_HEAD_DIM, SSM_STATE)


def mamba_mixer(xn, ssm_prev, conv_prev, w_in, conv_w, conv_b, dt_bias, a_log, d_skip, norm_g, w_out):
    bsz, L, _ = xn.shape
    f32 = jnp.float32
    proj = xn @ w_in
    z = proj[..., :SSM_INNER]
    xbc = proj[..., SSM_INNER:SSM_INNER + CONV_DIM]
    dt_raw = proj[..., SSM_INNER + CONV_DIM:]
    xbc, conv_new = causal_conv(xbc, conv_prev, conv_w, conv_b)
    gn = SSM_GROUPS * SSM_STATE
    xs = xbc[..., :SSM_INNER].reshape(bsz, L, SSM_HEADS, SSM_HEAD_DIM)
    Bm = xbc[..., SSM_INNER:SSM_INNER + gn].reshape(bsz, L, SSM_GROUPS, SSM_STATE)
    Cm = xbc[..., SSM_INNER + gn:].reshape(bsz, L, SSM_GROUPS, SSM_STATE)
    dt = jax.nn.softplus(dt_raw.astype(f32) + dt_bias.astype(f32))
    A = -jnp.exp(a_log.astype(f32))
    y, s_new = ssd_scan(xs, dt, A, Bm, Cm, ssm_prev, min(CHUNK, L))
    y = y + xs.astype(f32) * d_skip.astype(f32)[:, None]
    y = y.reshape(bsz, L, SSM_INNER) * jax.nn.silu(z.astype(f32))
    y = rmsnorm(y, norm_g).astype(xn.dtype)
    return y @ w_out, s_new.astype(ssm_prev.dtype), conv_new


def sink_softmax(scores, sinks):
    s = scores.astype(jnp.float32)
    sink = jnp.broadcast_to(sinks.astype(jnp.float32).reshape(KV_HEADS, Q_PER_KV, 1, 1), s.shape[:-1] + (1,))
    p = jax.nn.softmax(jnp.concatenate([s, sink], axis=-1), axis=-1)
    return p[..., :-1]


def swa_prompt(q, k, v, sinks):
    bsz, L = q.shape[:2]
    nc = L // CHUNK
    nk = (WIN_CHUNKS + 1) * CHUNK
    qb = q.reshape(bsz, nc, CHUNK, KV_HEADS, Q_PER_KV, ATTN_HEAD_DIM)
    pad = ((0, 0), (WINDOW, 0), (0, 0), (0, 0))
    kp = jnp.pad(k, pad).reshape(bsz, nc + WIN_CHUNKS, CHUNK, KV_HEADS, ATTN_HEAD_DIM)
    vp = jnp.pad(v, pad).reshape(bsz, nc + WIN_CHUNKS, CHUNK, KV_HEADS, ATTN_HEAD_DIM)
    kb = jnp.concatenate([kp[:, o:o + nc] for o in range(WIN_CHUNKS + 1)], axis=2)
    vb = jnp.concatenate([vp[:, o:o + nc] for o in range(WIN_CHUNKS + 1)], axis=2)
    scale = ATTN_HEAD_DIM ** -0.5
    scores = jnp.einsum('bcqkgd,bcskd->bckgqs', qb, kb).astype(jnp.float32) * scale
    key_chunk = jnp.arange(nc)[:, None] - WIN_CHUNKS + (jnp.arange(nk) // CHUNK)[None, :]
    valid = (key_chunk >= 0)[None, :, None, None, None, :]
    probs = sink_softmax(jnp.where(valid, scores, -jnp.inf), sinks)
    out = jnp.einsum('bckgqs,bcskd->bcqkgd', probs.astype(v.dtype), vb)
    return out.reshape(bsz, L, ATTN_HEADS * ATTN_HEAD_DIM)


def swa_sample(q, k_all, v_all, sinks):
    bsz, T = q.shape[:2]
    qh = q.reshape(bsz, T, KV_HEADS, Q_PER_KV, ATTN_HEAD_DIM)
    scale = ATTN_HEAD_DIM ** -0.5
    scores = jnp.einsum('btkgd,bskd->bkgts', qh, k_all).astype(jnp.float32) * scale
    probs = sink_softmax(scores, sinks)
    out = jnp.einsum('bkgts,bskd->btkgd', probs.astype(v_all.dtype), v_all)
    return out.reshape(bsz, T, ATTN_HEADS * ATTN_HEAD_DIM)


def peer(xn, w_q, sub_k1, sub_k2, u_tab, v_tab):
    bsz, L, D = xn.shape
    T = bsz * L
    nblk = -(-T // PEER_TOKEN_BLOCK)
    xt = jnp.pad(xn.reshape(T, D), ((0, nblk * PEER_TOKEN_BLOCK - T), (0, 0)))
    xt = xt.reshape(nblk, PEER_TOKEN_BLOCK, D)

    def block_fn(xb):
        q = (xb @ w_q).reshape(PEER_TOKEN_BLOCK, PEER_HEADS, PEER_QDIM)
        s1 = jnp.einsum('thd,nd->thn', q[..., :PEER_HALF], sub_k1)
        s2 = jnp.einsum('thd,nd->thn', q[..., PEER_HALF:], sub_k2)
        v1, i1 = lax.top_k(s1, PEER_TOPK)
        v2, i2 = lax.top_k(s2, PEER_TOPK)
        cand = (v1[..., :, None] + v2[..., None, :]).reshape(PEER_TOKEN_BLOCK, PEER_HEADS, PEER_TOPK * PEER_TOPK)
        vs, ci = lax.top_k(cand, PEER_TOPK)
        e1 = jnp.take_along_axis(i1, ci // PEER_TOPK, axis=-1)
        e2 = jnp.take_along_axis(i2, ci % PEER_TOPK, axis=-1)
        eid = (e1 * PEER_NKEYS + e2).reshape(PEER_TOKEN_BLOCK, PEER_HEADS * PEER_TOPK)
        gate = jax.nn.softmax(vs.astype(jnp.float32), axis=-1).reshape(PEER_TOKEN_BLOCK, PEER_HEADS * PEER_TOPK)
        ue = jnp.take(u_tab, eid, axis=0)
        act = jax.nn.gelu(jnp.einsum('tkd,td->tk', ue, xb).astype(jnp.float32))
        ve = jnp.take(v_tab, eid, axis=0)
        return jnp.einsum('tk,tkd->td', (gate * act).astype(xb.dtype), ve)

    out = lax.map(block_fn, xt)
    return out.reshape(nblk * PEER_TOKEN_BLOCK, D)[:T].reshape(bsz, L, D)


def setup_inputs(seed: int = 0) -> dict:
    key = jax.random.key(seed)
    ks = iter(jax.random.split(key, 48))

    def nrm(shape, scale):
        return jax.random.normal(next(ks), shape, jnp.float32) * scale

    D = D_MODEL
    HQD = ATTN_HEADS * ATTN_HEAD_DIM
    u_dt = jax.random.uniform(next(ks), (N_A_LAYERS, SSM_HEADS), jnp.float32)
    dt0 = jnp.exp(u_dt * (math.log(0.1) - math.log(0.001)) + math.log(0.001))
    return {
        'x_prompt': nrm((BATCH, SEQ, D), 1.0),
        'x_sample': nrm((DEC_BATCH, DEC_SEQ, D), 1.0),
        'state_ssm': nrm((N_A_LAYERS, DEC_BATCH, SSM_HEADS, SSM_HEAD_DIM, SSM_STATE), 0.1),
        'state_conv': nrm((N_A_LAYERS, DEC_BATCH, CONV_WIDTH - 1, CONV_DIM), 1.0),
        'cache_k_win': nrm((DEC_BATCH, WINDOW, KV_HEADS, ATTN_HEAD_DIM), 1.0),
        'cache_v_win': nrm((DEC_BATCH, WINDOW, KV_HEADS, ATTN_HEAD_DIM), 1.0),
        'norm_mix': 1.0 + nrm((DEPTH, D), 0.05),
        'norm_ffn': 1.0 + nrm((DEPTH, D), 0.05),
        'norm_kv': 1.0 + nrm((D,), 0.05),
        'norm_final': 1.0 + nrm((D,), 0.05),
        'm_w_in': nrm((N_A_LAYERS, D, SSM_IN_DIM), D ** -0.5),
        'm_conv_w': nrm((N_A_LAYERS, CONV_WIDTH, CONV_DIM), CONV_WIDTH ** -0.5),
        'm_conv_b': nrm((N_A_LAYERS, CONV_DIM), 0.01),
        'm_dt_bias': dt0 + jnp.log(-jnp.expm1(-dt0)),
        'm_a_log': jnp.log(jax.random.uniform(next(ks), (N_A_LAYERS, SSM_HEADS), jnp.float32, 1.0, 16.0)),
        'm_d_skip': 1.0 + nrm((N_A_LAYERS, SSM_HEADS), 0.1),
        'm_norm': 1.0 + nrm((N_A_LAYERS, SSM_INNER), 0.05),
        'm_w_out': nrm((N_A_LAYERS, SSM_INNER, D), SSM_INNER ** -0.5),
        'a_w_kv': nrm((D, 2 * KV_DIM), D ** -0.5),
        'a_b_kv': nrm((2 * KV_DIM,), 0.01),
        'a_w_q': nrm((N_B_LAYERS, D, HQD), D ** -0.5),
        'a_b_q': nrm((N_B_LAYERS, HQD), 0.01),
        'a_sinks': nrm((N_B_LAYERS, ATTN_HEADS), 0.5),
        'a_w_o': nrm((N_B_LAYERS, HQD, D), HQD ** -0.5),
        'a_b_o': nrm((N_B_LAYERS, D), 0.01),
        'p_w_q': nrm((DEPTH, D, PEER_HEADS * PEER_QDIM), D ** -0.5),
        'p_sub_k1': nrm((DEPTH, PEER_NKEYS, PEER_HALF), PEER_HALF ** -0.5),
        'p_sub_k2': nrm((DEPTH, PEER_NKEYS, PEER_HALF), PEER_HALF ** -0.5),
        'p_u': nrm((DEPTH, PEER_EXPERTS, D), D ** -0.5),
        'p_v': nrm((DEPTH, PEER_EXPERTS, D), (PEER_HEADS * PEER_TOPK) ** -0.5),
    }


def reference(x_prompt, x_sample, state_ssm, state_conv, cache_k_win, cache_v_win,
              norm_mix, norm_ffn, norm_kv, norm_final,
              m_w_in, m_conv_w, m_conv_b, m_dt_bias, m_a_log, m_d_skip, m_norm, m_w_out,
              a_w_kv, a_b_kv, a_w_q, a_b_q, a_sinks, a_w_o, a_b_o,
              p_w_q, p_sub_k1, p_sub_k2, p_u, p_v):

    def run(h, ssm_init, conv_init, k_prev, v_prev):
        bsz, L, _ = h.shape
        ssm_out, conv_out = [], []
        k_new = v_new = k_all = v_all = None
        for l in range(DEPTH):
            xn = rmsnorm(h, norm_mix[l])
            if l < N_A_LAYERS:
                mix, s_new, c_new = mamba_mixer(xn, ssm_init[l], conv_init[l], m_w_in[l], m_conv_w[l],
                                                m_conv_b[l], m_dt_bias[l], m_a_log[l], m_d_skip[l],
                                                m_norm[l], m_w_out[l])
                ssm_out.append(s_new)
                conv_out.append(c_new)
            else:
                j = l - N_A_LAYERS
                if j == 0:
                    kv = rmsnorm(h, norm_kv) @ a_w_kv + a_b_kv
                    k_new = kv[..., :KV_DIM].reshape(bsz, L, KV_HEADS, ATTN_HEAD_DIM)
                    v_new = kv[..., KV_DIM:].reshape(bsz, L, KV_HEADS, ATTN_HEAD_DIM)
                    if k_prev is not None:
                        k_all = jnp.concatenate([k_prev.astype(k_new.dtype), k_new], axis=1)
                        v_all = jnp.concatenate([v_prev.astype(v_new.dtype), v_new], axis=1)
                q = xn @ a_w_q[j] + a_b_q[j]
                if k_prev is None:
                    o = swa_prompt(q, k_new, v_new, a_sinks[j])
                else:
                    o = swa_sample(q, k_all, v_all, a_sinks[j])
                mix = o @ a_w_o[j] + a_b_o[j]
            h = h + mix
            h = h + peer(rmsnorm(h, norm_ffn[l]), p_w_q[l], p_sub_k1[l], p_sub_k2[l], p_u[l], p_v[l])
        y = rmsnorm(h, norm_final)
        if k_prev is None:
            k_win, v_win = k_new[:, -WINDOW:], v_new[:, -WINDOW:]
        else:
            k_win, v_win = k_all[:, -WINDOW:], v_all[:, -WINDOW:]
        return y, jnp.stack(ssm_out), jnp.stack(conv_out), k_win, v_win

    zeros_ssm = jnp.zeros((N_A_LAYERS, x_prompt.shape[0], SSM_HEADS, SSM_HEAD_DIM, SSM_STATE), x_prompt.dtype)
    zeros_conv = jnp.zeros((N_A_LAYERS, x_prompt.shape[0], CONV_WIDTH - 1, CONV_DIM), x_prompt.dtype)
    y_prompt, pr_ssm, pr_conv, pr_k_win, pr_v_win = run(x_prompt, zeros_ssm, zeros_conv, None, None)
    y_sample, sm_ssm, sm_conv, sm_k_win, sm_v_win = run(x_sample, state_ssm, state_conv, cache_k_win, cache_v_win)
    return (y_prompt, y_sample, pr_ssm, pr_conv, pr_k_win, pr_v_win, sm_ssm, sm_conv, sm_k_win, sm_v_win)
```

```cpp
#include <hip/hip_runtime.h>
#include <hip/hip_cooperative_groups.h>
#include <stdint.h>
#include <cstdio>

typedef unsigned short bf16_t;
typedef short bf16x8 __attribute__((ext_vector_type(8)));
typedef float f32x4 __attribute__((ext_vector_type(4)));
typedef unsigned u32x4 __attribute__((ext_vector_type(4)));
typedef unsigned u32x2 __attribute__((ext_vector_type(2)));
typedef float f32x2 __attribute__((ext_vector_type(2)));

#define T_P 16384
#define T_S 512
#define T_ALL 16896
#define DM 1024
#define NTHREADS 256
#define LAS __attribute__((address_space(3)))
#define SMEM_BYTES 65536
#define DYN_LDS_BYTES 81920

#define OFF_Y 0
#define OFF_PR_SSM 17301504
#define OFF_PR_CONV 21495808
#define OFF_PR_K 21692416
#define OFF_PR_V 21954560
#define OFF_SM_SSM 22216704
#define OFF_SM_CONV 38993920
#define OFF_SM_K 39780352
#define OFF_SM_V 40828928

struct Params {
    const float *x_prompt, *x_sample, *state_ssm, *state_conv, *cache_k, *cache_v;
    const float *norm_mix, *norm_ffn, *norm_kv, *norm_final;
    const float *m_w_in, *m_conv_w, *m_conv_b, *m_dt_bias, *m_a_log, *m_d_skip, *m_norm, *m_w_out;
    const float *a_w_kv, *a_b_kv, *a_w_q, *a_b_q, *a_sinks, *a_w_o, *a_b_o;
    const float *p_w_q, *p_sub_k1, *p_sub_k2, *p_u, *p_v;
    float* out;
    bf16_t *w_in_t, *w_out_t, *w_kv_t, *w_aq_t, *w_ao_t, *w_pq_t, *subk, *wq_b;
    unsigned char *u8, *v8;
    float* partial;
    unsigned char* wq;
    float* wscale;
    float *h, *h2;
    bf16_t *xn, *xn2, *bufA, *bufB, *zbuf;
    float *ssq_h, *ssq_h2, *ssq_y;
    float *dtsp, *decay, *dtraw, *ybuf, *kv;
    int* eid;
    float* gate;
    unsigned* bar;
    int ph_lo, ph_hi;
    int wv;
};

__device__ __forceinline__ float bf2f(bf16_t v) { return __uint_as_float(((unsigned)v) << 16); }
__device__ __forceinline__ bf16_t f2bf(float f) { unsigned r; asm("v_cvt_pk_bf16_f32 %0, %1, %1\n\ts_nop 1" : "=v"(r) : "v"(f)); return (bf16_t)(r & 0xffffu); }
__device__ __forceinline__ float bf_lo(unsigned u) { return __uint_as_float(u << 16); }
__device__ __forceinline__ float bf_hi(unsigned u) { return __uint_as_float(u & 0xffff0000u); }
__device__ __forceinline__ unsigned pk2(float lo, float hi) {
    unsigned r; asm("v_cvt_pk_bf16_f32 %0, %1, %2\n\ts_nop 1" : "=v"(r) : "v"(lo), "v"(hi)); return r;
}
__device__ __forceinline__ unsigned pk2_sw(float lo, float hi) {
    unsigned a = __float_as_uint(lo), b = __float_as_uint(hi);
    a += 0x7fffu + ((a >> 16) & 1u);
    b += 0x7fffu + ((b >> 16) & 1u);
    return (a >> 16) | (b & 0xffff0000u);
}
template <int CTRL> __device__ __forceinline__ float dpp_mov(float v) { return __int_as_float(__builtin_amdgcn_update_dpp(0, __float_as_int(v), CTRL, 0xf, 0xf, true)); }
template <int CTRL> __device__ __forceinline__ int dpp_movi(int v) { return __builtin_amdgcn_update_dpp(0, v, CTRL, 0xf, 0xf, true); }
__device__ __forceinline__ float row_sum16(float v) {
    v += dpp_mov<0xB1>(v); v += dpp_mov<0x4E>(v); v += dpp_mov<0x141>(v); v += dpp_mov<0x140>(v); return v;
}
__device__ __forceinline__ float xor16_sum(float v) { const auto r = __builtin_amdgcn_permlane16_swap(__float_as_uint(v), __float_as_uint(v), false, false); return __uint_as_float(r[0]) + __uint_as_float(r[1]); }
__device__ __forceinline__ float xor32_sum(float v) { const auto r = __builtin_amdgcn_permlane32_swap(__float_as_uint(v), __float_as_uint(v), false, false); return __uint_as_float(r[0]) + __uint_as_float(r[1]); }
__device__ __forceinline__ float xor16_max(float v) { const auto r = __builtin_amdgcn_permlane16_swap(__float_as_uint(v), __float_as_uint(v), false, false); return fmaxf(__uint_as_float(r[0]), __uint_as_float(r[1])); }
__device__ __forceinline__ float xor32_max(float v) { const auto r = __builtin_amdgcn_permlane32_swap(__float_as_uint(v), __float_as_uint(v), false, false); return fmaxf(__uint_as_float(r[0]), __uint_as_float(r[1])); }
__device__ __forceinline__ float wave_sum(float v) { return xor32_sum(xor16_sum(row_sum16(v))); }
__device__ __forceinline__ unsigned pack_fp8x4(float a, float b, float c, float d) {
    int w = 0; w = __builtin_amdgcn_cvt_pk_fp8_f32(a, b, w, false); w = __builtin_amdgcn_cvt_pk_fp8_f32(c, d, w, true); return (unsigned)w;
}
__device__ __forceinline__ unsigned pack_i8x4(float a, float b, float c, float d) {
    const int ia = max(-127, min(127, __float2int_rn(a))), ib = max(-127, min(127, __float2int_rn(b))), ic = max(-127, min(127, __float2int_rn(c))), id = max(-127, min(127, __float2int_rn(d)));
    return (unsigned)(ia & 255) | ((unsigned)(ib & 255) << 8) | ((unsigned)(ic & 255) << 16) | ((unsigned)(id & 255) << 24);
}
__device__ __forceinline__ int lt(int wv) { int t; asm volatile("v_mbcnt_lo_u32_b32 %0, -1, 0\n\tv_mbcnt_hi_u32_b32 %0, -1, %0\n\tv_lshl_or_b32 %0, %1, 6, %0" : "=&v"(t) : "s"(wv)); return t; }
__device__ __forceinline__ int lb() { int b = blockIdx.x; asm volatile("" : "+s"(b)); return b; }
#define TIDX lt(p.wv)
#define BIDX lb()
__device__ __forceinline__ float silu_f(float x) { return x * __builtin_amdgcn_rcpf(1.f + __expf(-x)); }
__device__ __forceinline__ float gelu_tanh(float x) {
    const float u = 0.7978845608028654f * (x + 0.044715f * x * x * x);
    const float t = 1.f - 2.f * __builtin_amdgcn_rcpf(__expf(2.f * u) + 1.f);
    return 0.5f * x * (1.f + t);
}

__device__ __forceinline__ void convert_tables(const Params& p, int l0, int nl, size_t vtid, size_t vstride) {
    const size_t np = (size_t)nl * 16384 * 64, base = (size_t)l0 * 16384 * 64;
    const int jfix = (int)(vtid & 63);
    f32x4 gu[2][4];
#pragma unroll
    for (int li = 0; li < 2; ++li)
#pragma unroll
        for (int k = 0; k < 4; ++k) gu[li][k] = *(const f32x4*)(p.norm_ffn + (size_t)(l0 + min(li, nl - 1)) * 1024 + 16 * jfix + 4 * k) * 512.f;
    for (size_t i0 = vtid; i0 < 2 * np; i0 += 4 * vstride) {
        f32x4 a[4][4]; bool ok[4];
#pragma unroll
        for (int u = 0; u < 4; ++u) {
            const size_t i = i0 + (size_t)u * vstride; ok[u] = i < 2 * np;
            if (ok[u]) {
                const bool isv = i >= np; const size_t q = base + (isv ? i - np : i);
                const float* s = (isv ? p.p_v : p.p_u) + (q >> 6) * 1024 + 16 * (q & 63);
#pragma unroll
                for (int k = 0; k < 4; ++k) a[u][k] = __builtin_nontemporal_load((const f32x4*)(s + 4 * k));
            }
        }
#pragma unroll
        for (int u = 0; u < 4; ++u) {
            const size_t i = i0 + (size_t)u * vstride;
            if (ok[u]) {
                const bool isv = i >= np; const size_t q = base + (isv ? i - np : i);
                const int j = (int)(q & 63), e = (int)((q >> 6) & 16383), l = (int)(q >> 20);
                f32x4 g[4];
#pragma unroll
                for (int k = 0; k < 4; ++k) g[k] = isv ? (f32x4){256.f, 256.f, 256.f, 256.f} : (l > l0 ? gu[1][k] : gu[0][k]);
                u32x4 o;
                { const f32x4 v = a[u][0] * g[0]; o.x = pack_i8x4(v.x, v.y, v.z, v.w); }
                { const f32x4 v = a[u][1] * g[1]; o.y = pack_i8x4(v.x, v.y, v.z, v.w); }
                { const f32x4 v = a[u][2] * g[2]; o.z = pack_i8x4(v.x, v.y, v.z, v.w); }
                { const f32x4 v = a[u][3] * g[3]; o.w = pack_i8x4(v.x, v.y, v.z, v.w); }
                unsigned char* dst = (isv ? p.v8 : p.u8) + (((size_t)l * 8 + (j >> 3)) * 16384 + e) * 128 + 16 * (j & 7);
                *(u32x4*)dst = o;
            }
        }
    }
}

struct TJob { const float* src; bf16_t* dst; int K, N, Npad; const float* gk; };
__device__ __forceinline__ TJob get_tjob(const Params& p, int j) {
    TJob t;
    if (j < 2) { t.src = p.m_w_in + (size_t)j * 1024 * 6176; t.dst = p.w_in_t + (size_t)j * 6272 * 1024; t.K = 1024; t.N = 6176; t.Npad = 6272; t.gk = p.norm_mix + (size_t)j * 1024; }
    else if (j < 4) { t.src = p.m_w_out + (size_t)(j - 2) * 2048 * 1024; t.dst = p.w_out_t + (size_t)(j - 2) * 1024 * 2048; t.K = 2048; t.N = 1024; t.Npad = 1024; t.gk = p.m_norm + (size_t)(j - 2) * 2048; }
    else if (j < 5) { t.src = p.a_w_kv; t.dst = p.w_kv_t; t.K = 1024; t.N = 512; t.Npad = 512; t.gk = p.norm_kv; }
    else if (j < 7) { t.src = p.a_w_q + (size_t)(j - 5) * 1024 * 1024; t.dst = p.w_aq_t + (size_t)(j - 5) * 1024 * 1024; t.K = 1024; t.N = 1024; t.Npad = 1024; t.gk = p.norm_mix + (size_t)(2 + j - 5) * 1024; }
    else if (j < 9) { t.src = p.a_w_o + (size_t)(j - 7) * 1024 * 1024; t.dst = p.w_ao_t + (size_t)(j - 7) * 1024 * 1024; t.K = 1024; t.N = 1024; t.Npad = 1024; t.gk = nullptr; }
    else { t.src = p.p_w_q + (size_t)(j - 9) * 1024 * 2048; t.dst = p.w_pq_t + (size_t)(j - 9) * 2048 * 1024; t.K = 1024; t.N = 2048; t.Npad = 2048; t.gk = p.norm_ffn + (size_t)(j - 9) * 1024; }
    return t;
}
#define N_TJOBS 9

__device__ __forceinline__ void convert_transposes(const Params& p, char* smem, int j0, int j1, int vb, int vG) {
    const int tid = TIDX;
    float* scr = (float*)smem;
    int total = 0;
    for (int j = j0; j < j1; ++j) { TJob t = get_tjob(p, j); total += (t.K / 64) * (t.Npad / 64); }
    for (int tile = vb; tile < total; tile += vG) {
        int r = tile, j = j0; TJob t = get_tjob(p, j0);
        for (;;) { const int n = (t.K / 64) * (t.Npad / 64); if (r < n) break; r -= n; ++j; t = get_tjob(p, j); }
        const int nnt = t.Npad / 64, kt = r / nnt, nt = r % nnt, k0 = kt * 64, n0 = nt * 64;
        __syncthreads();
        const float* gkp = t.gk ? t.gk : p.norm_mix;
        const bool has_g = t.gk != nullptr;
        float xv[16], gv[16];
#pragma unroll
        for (int i = 0; i < 16; ++i) {
            const int e = tid + 256 * i, kk = e >> 6, nn = e & 63;
            xv[i] = t.src[(size_t)(k0 + kk) * t.N + min(n0 + nn, t.N - 1)];
            gv[i] = gkp[k0 + kk];
        }
#pragma unroll
        for (int i = 0; i < 16; ++i) {
            const int e = tid + 256 * i, kk = e >> 6, nn = e & 63;
            const float v = xv[i] * (has_g ? gv[i] : 1.f);
            scr[kk * 65 + nn] = (n0 + nn < t.N) ? v : 0.f;
        }
        __syncthreads();
#pragma unroll
        for (int i = 0; i < 2; ++i) {
            const int e = tid + 256 * i, nn = e >> 3, c = e & 7;
            const float* s = scr + (8 * c) * 65 + nn;
            u32x4 o; o.x = pk2(s[0], s[65]); o.y = pk2(s[130], s[195]); o.z = pk2(s[260], s[325]); o.w = pk2(s[390], s[455]);
            *(u32x4*)(t.dst + (size_t)(n0 + nn) * t.K + k0 + 8 * c) = o;
        }
    }
}
__device__ __forceinline__ void phase_convert(const Params& p, char* smem) { convert_transposes(p, smem, 0, 1, BIDX, gridDim.x); }
__device__ __forceinline__ void convert_plain(const Params& p, size_t gtid, size_t gstride) {
    {
        const size_t n8 = (size_t)4 * 2 * 16384 / 8;
        for (size_t i = gtid; i < n8; i += gstride) {
            const size_t e = i * 8; const int l = (int)(e / 32768), hf = (int)((e / 16384) & 1); const size_t off = e & 16383;
            const float* s = (hf ? p.p_sub_k2 : p.p_sub_k1) + (size_t)l * 16384 + off;
            const f32x4 a = *(const f32x4*)s, b = *(const f32x4*)(s + 4);
            u32x4 o; o.x = pk2(a.x, a.y); o.y = pk2(a.z, a.w); o.z = pk2(b.x, b.y); o.w = pk2(b.z, b.w);
            *(u32x4*)(p.subk + e) = o;
        }
    }
    {
        const size_t n8 = (size_t)4 * 1024 * 2048 / 8;
        for (size_t i = gtid; i < n8; i += 4 * gstride) {
            f32x4 a[4], b[4]; float g[4];
#pragma unroll
            for (int u = 0; u < 4; ++u) {
                const size_t e = min(i + u * gstride, n8 - 1) * 8;
                g[u] = p.norm_ffn[e >> 11]; a[u] = *(const f32x4*)(p.p_w_q + e); b[u] = *(const f32x4*)(p.p_w_q + e + 4);
            }
#pragma unroll
            for (int u = 0; u < 4; ++u) {
                if (i + u * gstride < n8) {
                    const size_t e = (i + u * gstride) * 8;
                    const f32x4 av = a[u] * g[u], bv = b[u] * g[u];
                    u32x4 o; o.x = pk2(av.x, av.y); o.y = pk2(av.z, av.w); o.z = pk2(bv.x, bv.y); o.w = pk2(bv.z, bv.w);
                    *(u32x4*)(p.wq_b + e) = o;
                }
            }
        }
    }
}

__device__ __forceinline__ void wave_rmsnorm_store(const f32x4 (&v)[4], const float* g, bf16_t* dst, int lane) {
    float ss = 0.f;
#pragma unroll
    for (int i = 0; i < 4; ++i) ss += v[i].x * v[i].x + v[i].y * v[i].y + v[i].z * v[i].z + v[i].w * v[i].w;
    ss = wave_sum(ss);
    const float inv = rsqrtf(ss * (1.f / 1024.f) + 1e-6f);
#pragma unroll
    for (int i = 0; i < 4; ++i) {
        const f32x4 gv = *(const f32x4*)(g + i * 256 + lane * 4);
        u32x2 o; o.x = pk2(v[i].x * inv * gv.x, v[i].y * inv * gv.y); o.y = pk2(v[i].z * inv * gv.z, v[i].w * inv * gv.w);
        *(u32x2*)(dst + i * 256 + lane * 4) = o;
    }
}

__device__ __forceinline__ void phase_embed(const Params& p) {
    const int lane = TIDX & 63, gw = BIDX * 4 + p.wv, nw = gridDim.x * 4;
    for (int row0 = gw; row0 < T_ALL; row0 += 2 * nw) {
        f32x4 v[2][4];
#pragma unroll
        for (int u = 0; u < 2; ++u) {
            const int row = min(row0 + u * nw, T_ALL - 1);
            const float* src = row < T_P ? p.x_prompt + (size_t)row * DM : p.x_sample + (size_t)(row - T_P) * DM;
#pragma unroll
            for (int i = 0; i < 4; ++i) v[u][i] = *(const f32x4*)(src + i * 256 + lane * 4);
        }
#pragma unroll
        for (int u = 0; u < 2; ++u) {
            const int row = row0 + u * nw;
            if (row < T_ALL) {
                float ss = 0.f;
#pragma unroll
                for (int i = 0; i < 4; ++i) {
                    const f32x4 x = v[u][i];
                    *(f32x4*)(p.h + (size_t)row * DM + i * 256 + lane * 4) = x;
                    u32x2 o; o.x = pk2(x.x, x.y); o.y = pk2(x.z, x.w);
                    *(u32x2*)(p.xn + (size_t)row * DM + i * 256 + lane * 4) = o;
                    ss += x.x * x.x + x.y * x.y + x.z * x.z + x.w * x.w;
                }
                ss = wave_sum(ss);
                if (lane < 8) p.ssq_h[(size_t)row * 8 + lane] = lane == 0 ? ss : 0.f;
            }
        }
    }
}

__device__ __forceinline__ int lds_off(int r, int c) { return r * 128 + ((c ^ ((r >> 1) & 7)) << 4); }

struct RowScale { const float* part; int nparts; float inv_dim; };
template <int MFR, class Epi>
__device__ __forceinline__ void gemm_tile(const bf16_t* __restrict__ A, int lda, const bf16_t* __restrict__ Bt, int ldb, int K,
                                          int m0, int n0, char* smem, const Epi& epi, const RowScale& rs, int wv, bool first = true, bool has_next = false, int m0n = 0, int n0n = 0) {
    const int tid = lt(wv), lane = tid & 63, wid = wv, wm = wid >> 1, wn = wid & 1;
    constexpr int AB = MFR > 4 ? MFR * 4096 : 16384, STG = AB + 16384;
    f32x4 acc[4][MFR];
#pragma unroll
    for (int a = 0; a < 4; ++a)
#pragma unroll
        for (int b = 0; b < MFR; ++b) acc[a][b] = (f32x4){0.f, 0.f, 0.f, 0.f};
    const int nk = K / 64;
    const int srow = wid * 8 + (lane >> 3), schunk = (lane & 7) ^ ((srow >> 1) & 7);
    const bf16_t* ga = A + (size_t)(m0 + srow) * lda + schunk * 8;
    const bf16_t* gb = Bt + (size_t)(n0 + srow) * ldb + schunk * 8;
    auto stage2 = [&](const bf16_t* ga, const bf16_t* gb, int kt, char* buf) {
#pragma unroll
        for (int i = 0; i < (MFR > 4 ? MFR : 4); ++i) {
            if (i < MFR) __builtin_amdgcn_global_load_lds((const unsigned*)(ga + (size_t)(32 * i) * lda + kt * 64), (LAS unsigned*)(buf + (4 * i + wid) * 1024), 16, 0, 0);
            if (i < 4) __builtin_amdgcn_global_load_lds((const unsigned*)(gb + (size_t)(32 * i) * ldb + kt * 64), (LAS unsigned*)(buf + AB + (4 * i + wid) * 1024), 16, 0, 0);
        }
    };
    auto stage = [&](int kt, char* buf) { stage2(ga, gb, kt, buf); };
    bf16x8 xf[2][MFR], wf[2][4];
    auto rd = [&](int fb, const char* cur, int kk) {
        const int c = kk * 4 + (lane >> 4);
#pragma unroll
        for (int im = 0; im < MFR; ++im) xf[fb][im] = *(const bf16x8*)(cur + lds_off(wm * (16 * MFR) + im * 16 + (lane & 15), c));
#pragma unroll
        for (int jn = 0; jn < 4; ++jn) wf[fb][jn] = *(const bf16x8*)(cur + AB + lds_off(wn * 64 + jn * 16 + (lane & 15), c));
    };
    auto mm = [&](int fb, int j0, int j1) {
        __builtin_amdgcn_s_setprio(1);
#pragma unroll
        for (int jn = j0; jn < j1; ++jn)
#pragma unroll
            for (int im = 0; im < MFR; ++im) acc[jn][im] = __builtin_amdgcn_mfma_f32_16x16x32_bf16(wf[fb][jn], xf[fb][im], acc[jn][im], 0, 0, 0);
        __builtin_amdgcn_s_setprio(0);
    };
    if (first) {
        __syncthreads();
        stage(0, smem);
        asm volatile("s_waitcnt vmcnt(0)" ::: "memory");
        __syncthreads();
        if (nk > 1) stage(1, smem + STG);
    } else {
        asm volatile("s_waitcnt vmcnt(0)" ::: "memory");
        __syncthreads();
    }
    rd(0, smem, 0);
    for (int kt = 0; kt < nk; ++kt) {
        char* cur = smem + (kt & 1) * STG;
        char* nxt = smem + ((kt + 1) & 1) * STG;
        mm(0, 0, 1);
        __builtin_amdgcn_sched_barrier(0);
        rd(1, cur, 1);
        __builtin_amdgcn_sched_barrier(0);
        mm(0, 1, 4);
        __builtin_amdgcn_sched_barrier(0);
        asm volatile("s_waitcnt vmcnt(0) lgkmcnt(0)" ::: "memory");
        __syncthreads();
        if (kt + 2 < nk) stage(kt + 2, cur);
        else if (has_next) { const int tl = lt(wv), sr = wv * 8 + ((tl & 63) >> 3), sc = (tl & 7) ^ ((sr >> 1) & 7);
                             stage2(A + (size_t)(m0n + sr) * lda + sc * 8, Bt + (size_t)(n0n + sr) * ldb + sc * 8, kt + 2 - nk, cur); }
        if (kt + 1 < nk) rd(0, nxt, 0);
        __builtin_amdgcn_sched_barrier(0);
        mm(1, 0, 4);
        __builtin_amdgcn_sched_barrier(0);
    }
    f32x4 addv[Epi::kHasPre ? 4 : 1][Epi::kHasPre ? MFR : 1];
    if (Epi::kHasPre) {
#pragma unroll
        for (int im = 0; im < MFR; ++im)
#pragma unroll
            for (int jn = 0; jn < 4; ++jn) addv[Epi::kHasPre ? jn : 0][Epi::kHasPre ? im : 0] = epi.pre(m0 + wm * (16 * MFR) + im * 16 + (lane & 15), n0 + wn * 64 + jn * 16 + (lane >> 4) * 4);
        __builtin_amdgcn_sched_barrier(0);
    }
    float rsc[MFR > 4 ? MFR : 4];
#pragma unroll
    for (int i = 0; i < (MFR > 4 ? MFR : 4); ++i) rsc[i] = 1.f;
    if (rs.part) {
        const int per = rs.nparts >> 2;
        f32x2 pvv[MFR][4];
#pragma unroll
        for (int im = 0; im < MFR; ++im) {
            const float* pp = rs.part + (size_t)(m0 + wm * (16 * MFR) + im * 16 + (lane & 15)) * rs.nparts + (lane >> 4) * per;
#pragma unroll
            for (int q = 0; q < 4; ++q) pvv[im][q] = *(const f32x2*)(pp + min(2 * q, per - 2));
        }
        __builtin_amdgcn_sched_barrier(0);
#pragma unroll
        for (int im = 0; im < MFR; ++im) {
            float sm = 0.f;
#pragma unroll
            for (int q = 0; q < 4; ++q) sm += (2 * q < per) ? pvv[im][q].x + pvv[im][q].y : 0.f;
            sm = xor32_sum(xor16_sum(sm));
            rsc[im] = rsqrtf(sm * rs.inv_dim + 1e-6f);
        }
    }
    if (Epi::kResPack) {
        const int q4 = lane >> 4;
#pragma unroll
        for (int im = 0; im < MFR; ++im) {
            const int m = m0 + wm * (16 * MFR) + im * 16 + (lane & 15);
            f32x4 o[4]; float ss = 0.f;
#pragma unroll
            for (int jn = 0; jn < 4; ++jn) { o[jn] = epi.res4(m, n0 + wn * 64 + jn * 16 + q4 * 4, acc[jn][im] * rsc[im], addv[Epi::kHasPre ? jn : 0][Epi::kHasPre ? im : 0]); ss += (o[jn].x * o[jn].x + o[jn].y * o[jn].y) + (o[jn].z * o[jn].z + o[jn].w * o[jn].w); }
#pragma unroll
            for (int jp = 0; jp < 2; ++jp) {
                const unsigned ax = pk2(o[2 * jp].x, o[2 * jp].y), ay = pk2(o[2 * jp].z, o[2 * jp].w), bx = pk2(o[2 * jp + 1].x, o[2 * jp + 1].y), by = pk2(o[2 * jp + 1].z, o[2 * jp + 1].w);
                const auto s0 = __builtin_amdgcn_permlane16_swap(ax, bx, false, false), s1 = __builtin_amdgcn_permlane16_swap(ay, by, false, false);
                const u32x4 w = {s0[0], s1[0], s0[1], s1[1]};
                epi.store16(m, n0 + wn * 64 + (2 * jp + (q4 & 1)) * 16 + (q4 & 2) * 4, w);
            }
            ss = xor32_sum(xor16_sum(ss)); if (q4 == 0) epi.put_ss(m, (n0 >> 7) * 2 + wn, ss);
        }
        return;
    }
    if (Epi::kPack16 && epi.pack_ok(n0)) {
        const int q4 = lane >> 4;
#pragma unroll
        for (int im = 0; im < MFR; ++im) {
            const int m = m0 + wm * (16 * MFR) + im * 16 + (lane & 15);
#pragma unroll
            for (int jp = 0; jp < 2; ++jp) {
                const u32x2 a = epi.pack4(acc[2 * jp][im] * rsc[im], addv[Epi::kHasPre ? 2 * jp : 0][Epi::kHasPre ? im : 0]), b = epi.pack4(acc[2 * jp + 1][im] * rsc[im], addv[Epi::kHasPre ? 2 * jp + 1 : 0][Epi::kHasPre ? im : 0]);
                const auto s0 = __builtin_amdgcn_permlane16_swap(a.x, b.x, false, false), s1 = __builtin_amdgcn_permlane16_swap(a.y, b.y, false, false);
                const u32x4 w = {s0[0], s1[0], s0[1], s1[1]};
                epi.store16(m, n0 + wn * 64 + (2 * jp + (q4 & 1)) * 16 + (q4 & 2) * 4, w);
            }
        }
        return;
    }
#pragma unroll
    for (int im = 0; im < MFR; ++im) {
        const int m = m0 + wm * (16 * MFR) + im * 16 + (lane & 15);
        float ss = 0.f;
#pragma unroll
        for (int jn = 0; jn < 4; ++jn) ss += epi.store4(m, n0 + wn * 64 + jn * 16 + (lane >> 4) * 4, acc[jn][im] * rsc[im], addv[Epi::kHasPre ? jn : 0][Epi::kHasPre ? im : 0]);
        if (Epi::kWantSS) { ss = xor32_sum(xor16_sum(ss)); if ((lane >> 4) == 0) epi.put_ss(m, (n0 >> 7) * 2 + wn, ss); }
    }
}

template <int MFR, class Epi>
__device__ __forceinline__ void gemm_phase(const bf16_t* A, int lda, const bf16_t* Bt, int ldb, int K, int M, int N, char* smem, const Epi& epi, const RowScale& rs, int wv) {
    const int mt = M / (32 * MFR), nt = N / 128, nwg = mt * nt, G = gridDim.x, bid = BIDX;
    auto tile_of = [&](int L, int& im, int& in) {
        int wgid;
        { const int q = nwg >> 3, r = nwg & 7, xcd = L & 7, off = L >> 3; wgid = (xcd < r ? xcd * (q + 1) : r * (q + 1) + (xcd - r) * q) + off; }
        const int nig = 8 * nt, gid = wgid / nig, fm = gid * 8, gsz = (mt - fm) < 8 ? (mt - fm) : 8;
        im = fm + ((wgid % nig) % gsz); in = (wgid % nig) / gsz;
    };
    for (int L = bid; L < nwg; L += G) {
        int im, in, imn = 0, inn = 0;
        tile_of(L, im, in);
        const bool has_next = L + G < nwg;
        if (has_next) tile_of(L + G, imn, inn);
        gemm_tile<MFR>(A, lda, Bt, ldb, K, im * 32 * MFR, in * 128, smem, epi, rs, wv, L == bid, has_next, imn * 32 * MFR, inn * 128);
    }
    if (MFR > 4) { __syncthreads(); if (lt(wv) == 0) { volatile LAS unsigned* stw = (volatile LAS unsigned*)(smem + DYN_LDS_BYTES - 16); stw[0] = 0u; stw[1] = 0u; } }
}

struct EpiInProj {
    static constexpr bool kWantSS = false, kHasPre = false, kHasBias = false, kPack16 = true, kResPack = false;
    bf16_t* z; bf16_t* xbc; float* dtraw;
    __device__ __forceinline__ f32x4 pre(int, int) const { return (f32x4){0.f, 0.f, 0.f, 0.f}; }
    __device__ __forceinline__ bool pack_ok(int n0) const { return n0 < 6144; }
    __device__ __forceinline__ f32x4 res4(int, int, const f32x4& v, const f32x4&) const { return v; }
    __device__ __forceinline__ u32x2 pack4(const f32x4& v, const f32x4&) const { u32x2 o; o.x = pk2(v.x, v.y); o.y = pk2(v.z, v.w); return o; }
    __device__ __forceinline__ void store16(int m, int n, const u32x4& w) const {
        if (n < 2048) *(u32x4*)(z + (size_t)m * 2048 + n) = w; else *(u32x4*)(xbc + (size_t)m * 4096 + (n - 2048)) = w;
    }
    __device__ __forceinline__ float store4(int m, int n, const f32x4& v, const f32x4&) const {
        if (n < 2048) { u32x2 o; o.x = pk2(v.x, v.y); o.y = pk2(v.z, v.w); *(u32x2*)(z + (size_t)m * 2048 + n) = o; }
        else if (n < 6144) { u32x2 o; o.x = pk2(v.x, v.y); o.y = pk2(v.z, v.w); *(u32x2*)(xbc + (size_t)m * 4096 + (n - 2048)) = o; }
        else if (n < 6176) { *(f32x4*)(dtraw + (size_t)m * 32 + (n - 6144)) = v; }
        return 0.f;
    }
    __device__ __forceinline__ void put_ss(int, int, float) const {}
};
template <bool HB>
struct EpiResidual {
    static constexpr bool kWantSS = true, kHasPre = true, kHasBias = false, kPack16 = false, kResPack = true;
    __device__ __forceinline__ bool pack_ok(int) const { return false; }
    __device__ __forceinline__ u32x2 pack4(const f32x4&, const f32x4&) const { return (u32x2){0u, 0u}; }
    __device__ __forceinline__ f32x4 res4(int m, int n, const f32x4& v, const f32x4& add) const { const f32x4 o = add + v; *(f32x4*)(hout + (size_t)m * DM + n) = o; return o; }
    __device__ __forceinline__ void store16(int m, int n, const u32x4& w) const { *(u32x4*)(hb + (size_t)m * DM + n) = w; }
    const float* hin; float* hout; bf16_t* hb; float* ssq; const float* bias;
    __device__ __forceinline__ f32x4 pre(int m, int n) const {
        const f32x4 r = *(const f32x4*)(hin + (size_t)m * DM + n);
        if (HB) return r + *(const f32x4*)(bias + n);
        return r;
    }
    __device__ __forceinline__ float store4(int m, int n, const f32x4& v, const f32x4& add) const {
        f32x4 o = add + v;
        *(f32x4*)(hout + (size_t)m * DM + n) = o;
        u32x2 w; w.x = pk2(o.x, o.y); w.y = pk2(o.z, o.w);
        *(u32x2*)(hb + (size_t)m * DM + n) = w;
        return (o.x * o.x + o.y * o.y) + (o.z * o.z + o.w * o.w);
    }
    __device__ __forceinline__ void put_ss(int m, int idx, float ss) const { ssq[(size_t)m * 16 + idx] = ss; }
};
template <bool HB>
struct EpiBf16 {
    static constexpr bool kWantSS = false, kHasPre = HB, kHasBias = false, kPack16 = true, kResPack = false;
    bf16_t* out; int ld; const float* bias;
    __device__ __forceinline__ bool pack_ok(int) const { return true; }
    __device__ __forceinline__ f32x4 res4(int, int, const f32x4& v, const f32x4&) const { return v; }
    __device__ __forceinline__ u32x2 pack4(const f32x4& v, const f32x4& add) const { f32x4 q = v; if (HB) q += add; u32x2 o; o.x = pk2(q.x, q.y); o.y = pk2(q.z, q.w); return o; }
    __device__ __forceinline__ void store16(int m, int n, const u32x4& w) const { *(u32x4*)(out + (size_t)m * ld + n) = w; }
    __device__ __forceinline__ f32x4 pre(int, int n) const { if (HB) return *(const f32x4*)(bias + n); return (f32x4){0.f, 0.f, 0.f, 0.f}; }
    __device__ __forceinline__ float store4(int m, int n, const f32x4& v, const f32x4& add) const {
        f32x4 o = v; if (HB) o += add;
        u32x2 w; w.x = pk2(o.x, o.y); w.y = pk2(o.z, o.w);
        *(u32x2*)(out + (size_t)m * ld + n) = w;
        return 0.f;
    }
    __device__ __forceinline__ void put_ss(int, int, float) const {}
};
struct EpiTransBf16 {
    static constexpr bool kWantSS = false, kHasPre = false, kHasBias = false, kPack16 = false, kResPack = false;
    bf16_t* out; int ld;
    __device__ __forceinline__ bool pack_ok(int) const { return false; }
    __device__ __forceinline__ f32x4 res4(int, int, const f32x4& v, const f32x4&) const { return v; }
    __device__ __forceinline__ u32x2 pack4(const f32x4&, const f32x4&) const { return (u32x2){0u, 0u}; }
    __device__ __forceinline__ void store16(int, int, const u32x4&) const {}
    __device__ __forceinline__ f32x4 pre(int, int) const { return (f32x4){0.f, 0.f, 0.f, 0.f}; }
    __device__ __forceinline__ float store4(int m, int n, const f32x4& v, const f32x4&) const {
        const unsigned a = pk2_sw(v.x, v.y), b = pk2_sw(v.z, v.w);
        out[(size_t)n * ld + m] = (bf16_t)(a & 0xffffu); out[(size_t)(n + 1) * ld + m] = (bf16_t)(a >> 16); out[(size_t)(n + 2) * ld + m] = (bf16_t)(b & 0xffffu); out[(size_t)(n + 3) * ld + m] = (bf16_t)(b >> 16);
        return 0.f;
    }
    __device__ __forceinline__ void put_ss(int, int, float) const {}
};
template <bool HB>
struct EpiF32 {
    static constexpr bool kWantSS = false, kHasPre = HB, kHasBias = false, kPack16 = false, kResPack = false;
    float* out; int ld; int coloff; const float* bias;
    __device__ __forceinline__ bool pack_ok(int) const { return false; }
    __device__ __forceinline__ f32x4 res4(int, int, const f32x4& v, const f32x4&) const { return v; }
    __device__ __forceinline__ u32x2 pack4(const f32x4&, const f32x4&) const { return (u32x2){0u, 0u}; }
    __device__ __forceinline__ void store16(int, int, const u32x4&) const {}
    __device__ __forceinline__ f32x4 pre(int, int n) const { if (HB) return *(const f32x4*)(bias + n); return (f32x4){0.f, 0.f, 0.f, 0.f}; }
    __device__ __forceinline__ float store4(int m, int n, const f32x4& v, const f32x4& add) const {
        f32x4 o = v; if (HB) o += add;
        *(f32x4*)(out + (size_t)m * ld + coloff + n) = o;
        return 0.f;
    }
    __device__ __forceinline__ void put_ss(int, int, float) const {}
};

__device__ __forceinline__ void phase_conv(const Params& p, int l) {
    const size_t gtid = (size_t)BIDX * NTHREADS + TIDX, gstride = (size_t)gridDim.x * NTHREADS;
    const float* cw = p.m_conv_w + (size_t)l * 4 * 4096;
    const float* cb = p.m_conv_b + (size_t)l * 4096;
    const bf16_t* xr = p.bufA;
    bf16_t* xc = p.bufB;
    const size_t nitems = (size_t)(T_ALL / 4) * 512;
    const int c0 = (int)(gtid & 511) * 8;
    float wk[4][8], bias[8];
    {
#pragma unroll
        for (int k = 0; k < 4; ++k) {
            const f32x4 w0 = *(const f32x4*)(cw + k * 4096 + c0), w1 = *(const f32x4*)(cw + k * 4096 + c0 + 4);
            wk[k][0] = w0.x; wk[k][1] = w0.y; wk[k][2] = w0.z; wk[k][3] = w0.w; wk[k][4] = w1.x; wk[k][5] = w1.y; wk[k][6] = w1.z; wk[k][7] = w1.w;
        }
        const f32x4 b0 = *(const f32x4*)(cb + c0), b1 = *(const f32x4*)(cb + c0 + 4);
        bias[0] = b0.x; bias[1] = b0.y; bias[2] = b0.z; bias[3] = b0.w; bias[4] = b1.x; bias[5] = b1.y; bias[6] = b1.z; bias[7] = b1.w;
    }
    auto ldrows = [&](size_t it, u32x4 (&raw)[7]) {
        const int t0 = (int)(it >> 9) * 4;
#pragma unroll
        for (int r = 0; r < 7; ++r) raw[r] = *(const u32x4*)(xr + (size_t)max(t0 - 3 + r, 0) * 4096 + c0);
    };
    auto compute = [&](size_t it, const u32x4 (&raw)[7]) {
        const int t0 = (int)(it >> 9) * 4;
        int b, pos0, L; const float* prev = nullptr; float* cso;
        if (t0 < T_P) { b = t0 >> 11; pos0 = t0 & 2047; L = 2048; cso = p.out + OFF_PR_CONV + ((size_t)l * 8 + b) * 3 * 4096; }
        else { const int ts = t0 - T_P; b = ts >> 4; pos0 = ts & 15; L = 16; prev = p.state_conv + ((size_t)l * 32 + b) * 3 * 4096; cso = p.out + OFF_SM_CONV + ((size_t)l * 32 + b) * 3 * 4096; }
        float xv[7][8];
#pragma unroll
        for (int r = 0; r < 7; ++r) {
            const u32x4 u = raw[r];
            xv[r][0] = bf_lo(u.x); xv[r][1] = bf_hi(u.x); xv[r][2] = bf_lo(u.y); xv[r][3] = bf_hi(u.y); xv[r][4] = bf_lo(u.z); xv[r][5] = bf_hi(u.z); xv[r][6] = bf_lo(u.w); xv[r][7] = bf_hi(u.w);
        }
        if (pos0 == 0) {
#pragma unroll
            for (int r = 0; r < 3; ++r) {
                if (prev) {
                    const f32x4 a = *(const f32x4*)(prev + (size_t)r * 4096 + c0), bq = *(const f32x4*)(prev + (size_t)r * 4096 + c0 + 4);
                    xv[r][0] = a.x; xv[r][1] = a.y; xv[r][2] = a.z; xv[r][3] = a.w; xv[r][4] = bq.x; xv[r][5] = bq.y; xv[r][6] = bq.z; xv[r][7] = bq.w;
                } else {
#pragma unroll
                    for (int j = 0; j < 8; ++j) xv[r][j] = 0.f;
                }
            }
        }
#pragma unroll
        for (int o4 = 0; o4 < 4; ++o4) {
            float acc[8];
#pragma unroll
            for (int j = 0; j < 8; ++j) acc[j] = bias[j] + xv[o4][j] * wk[0][j] + xv[o4 + 1][j] * wk[1][j] + xv[o4 + 2][j] * wk[2][j] + xv[o4 + 3][j] * wk[3][j];
            u32x4 o;
            o.x = pk2(silu_f(acc[0]), silu_f(acc[1])); o.y = pk2(silu_f(acc[2]), silu_f(acc[3]));
            o.z = pk2(silu_f(acc[4]), silu_f(acc[5])); o.w = pk2(silu_f(acc[6]), silu_f(acc[7]));
            *(u32x4*)(xc + (size_t)(t0 + o4) * 4096 + c0) = o;
            const int pos = pos0 + o4;
            if (pos >= L - 3) {
                float* d = cso + (size_t)(pos - (L - 3)) * 4096 + c0;
                *(f32x4*)d = (f32x4){xv[o4 + 3][0], xv[o4 + 3][1], xv[o4 + 3][2], xv[o4 + 3][3]};
                *(f32x4*)(d + 4) = (f32x4){xv[o4 + 3][4], xv[o4 + 3][5], xv[o4 + 3][6], xv[o4 + 3][7]};
            }
        }
    };
    if (gtid < nitems) {
        u32x4 rawA[7], rawB[7];
        size_t it = gtid;
        ldrows(it, rawA);
        for (;;) {
            size_t itn = it + gstride;
            ldrows(min(itn, nitems - 1), rawB);
            __builtin_amdgcn_sched_barrier(0);
            compute(it, rawA);
            it = itn; if (it >= nitems) break;
            itn = it + gstride;
            ldrows(min(itn, nitems - 1), rawA);
            __builtin_amdgcn_sched_barrier(0);
            compute(it, rawB);
            it = itn; if (it >= nitems) break;
        }
    }
    for (size_t it = gtid; it < (size_t)T_ALL * 32; it += gstride) {
        const int hh = (int)(it & 31);
        const float x = p.dtraw[it] + p.m_dt_bias[l * 32 + hh];
        const float dt = x > 20.f ? x : __logf(1.f + __expf(x));
        const float A = -__expf(p.m_a_log[l * 32 + hh]);
        p.dtsp[it] = dt;
        p.decay[it] = __expf(dt * A);
    }
}

#define SSD_MS 144u
#define SSD_XS 144u
#define SSD_MT 32768u
#define SSD_XT 41984u
#define SSD_ZT 51200u
#define SSD_AR 60416u
__device__ __forceinline__ unsigned off_b(unsigned row, unsigned ch) { return 256u * row + 16u * (ch ^ (((row & 3u) << 2) | ((row >> 2) & 3u))); }
__device__ __forceinline__ void tr_read8(u32x2 (&d)[8], const unsigned (&a)[8]) {
    asm volatile("ds_read_b64_tr_b16 %0, %8\n\tds_read_b64_tr_b16 %1, %9\n\tds_read_b64_tr_b16 %2, %10\n\tds_read_b64_tr_b16 %3, %11\n\t"
                 "ds_read_b64_tr_b16 %4, %12\n\tds_read_b64_tr_b16 %5, %13\n\tds_read_b64_tr_b16 %6, %14\n\tds_read_b64_tr_b16 %7, %15\n\ts_waitcnt lgkmcnt(0)"
                 : "=&v"(d[0]), "=&v"(d[1]), "=&v"(d[2]), "=&v"(d[3]), "=&v"(d[4]), "=&v"(d[5]), "=&v"(d[6]), "=&v"(d[7])
                 : "v"(a[0]), "v"(a[1]), "v"(a[2]), "v"(a[3]), "v"(a[4]), "v"(a[5]), "v"(a[6]), "v"(a[7]) : "memory");
}
__device__ __forceinline__ void tr_read4(u32x2 (&d)[4], const unsigned (&a)[4]) {
    asm volatile("ds_read_b64_tr_b16 %0, %4\n\tds_read_b64_tr_b16 %1, %5\n\tds_read_b64_tr_b16 %2, %6\n\tds_read_b64_tr_b16 %3, %7\n\ts_waitcnt lgkmcnt(0)"
                 : "=&v"(d[0]), "=&v"(d[1]), "=&v"(d[2]), "=&v"(d[3]) : "v"(a[0]), "v"(a[1]), "v"(a[2]), "v"(a[3]) : "memory");
}
__device__ __forceinline__ bf16x8 frag8(const u32x2& lo, const u32x2& hi) { u32x4 v; v.x = lo.x; v.y = lo.y; v.z = hi.x; v.w = hi.y; return __builtin_bit_cast(bf16x8, v); }

__device__ __forceinline__ void phase_ssd(const Params& p, int l, char* smem) {
    const int tid = TIDX, lane = tid & 63, w = p.wv;
    const int q4 = lane >> 4, c16 = lane & 15;
    const unsigned g = lane >> 4, tq = (lane & 15) >> 2, tp = lane & 3;
    char* Bt = smem; char* Ct = smem + 16384; char* Mt = smem + SSD_MT; char* Xt = smem + SSD_XT; char* Zt = smem + SSD_ZT;
    float* acum = (float*)(smem + SSD_AR); float* dtv = acum + 64; float* wv = acum + 128; float* eA = acum + 192; float* cdec = acum + 256; float* ssql = acum + 260;
    const unsigned lbase = (unsigned)(size_t)smem;
    const bf16_t* xc = p.bufB;
    const int ssd_bid = BIDX, ssd_G = gridDim.x;
    const bool split = ssd_G >= 512;
    const int it_first = split ? (ssd_bid < 256 ? ssd_bid : 256 + (ssd_bid - 256)) : ssd_bid;
    const int it_end = split ? (ssd_bid < 256 ? ssd_bid + 1 : 256 + 1024) : 256 + 1024;
    const int it_step = split ? (ssd_G - 256) : ssd_G;
    for (int item = it_first; item < it_end; item += it_step) {
        int b, hh, nchunks, nvalid, row0; size_t soff; bool has_init;
        if (item < 256) { b = item >> 5; hh = item & 31; nchunks = 32; nvalid = 64; row0 = b * 2048; has_init = false;
                          soff = (size_t)OFF_PR_SSM + (((size_t)l * 8 + b) * 32 + hh) * 8192; }
        else { const int it = item - 256; b = it >> 5; hh = it & 31; nchunks = 1; nvalid = 16; row0 = T_P + b * 16; has_init = true;
               soff = (size_t)OFF_SM_SSM + (((size_t)l * 32 + b) * 32 + hh) * 8192; }
        float* so = p.out + soff;
        const float* si = p.state_ssm + (((size_t)l * 32 + b) * 32 + hh) * 8192;
        const int grp = hh >> 2;
        const float Ah = -__expf(p.m_a_log[l * 32 + hh]), dsk = p.m_d_skip[l * 32 + hh];
        f32x4 sT[8];
#pragma unroll
        for (int nt = 0; nt < 8; ++nt) {
            f32x4 v = (f32x4){0.f, 0.f, 0.f, 0.f};
            if (has_init) v = *(const f32x4*)(si + (size_t)(16 * w + c16) * 128 + 16 * nt + 4 * q4);
            sT[nt] = v;
        }
        __syncthreads();
        u32x4 rB[4], rC[4], rX[2]; float rdt = 0.f;
        auto load_chunk = [&](int c) {
            const int tid = TIDX;
#pragma unroll
            for (int k = 0; k < 4; ++k) {
                const int id = tid + 256 * k, row = id >> 4, ch = id & 15;
                if (row < nvalid) {
                    const bf16_t* src = xc + (size_t)(row0 + c * 64 + row) * 4096 + 2048 + grp * 128 + ch * 8;
                    rB[k] = *(const u32x4*)src; rC[k] = *(const u32x4*)(src + 1024);
                } else { rB[k] = (u32x4){0u, 0u, 0u, 0u}; rC[k] = (u32x4){0u, 0u, 0u, 0u}; }
            }
#pragma unroll
            for (int k = 0; k < 2; ++k) {
                const int id = tid + 256 * k, row = id >> 3, ch = id & 7;
                if (row < nvalid) rX[k] = *(const u32x4*)(xc + (size_t)(row0 + c * 64 + row) * 4096 + hh * 64 + ch * 8);
                else rX[k] = (u32x4){0u, 0u, 0u, 0u};
            }
            if (tid < 64) rdt = (tid < nvalid) ? p.dtsp[(size_t)(row0 + c * 64 + tid) * 32 + hh] : 0.f;
        };
        load_chunk(0);
        for (int c = 0; c < nchunks; ++c) {
#pragma unroll
            for (int k = 0; k < 4; ++k) {
                const unsigned id = tid + 256 * k, row = id >> 4, ch = id & 15;
                *(u32x4*)(Bt + off_b(row, ch)) = rB[k];
                *(u32x4*)(Ct + off_b(row, ch)) = rC[k];
            }
#pragma unroll
            for (int k = 0; k < 2; ++k) {
                const unsigned id = tid + 256 * k, row = id >> 3, ch = id & 7;
                *(u32x4*)(Xt + row * SSD_XS + ch * 16) = rX[k];
            }
            if (w == 0) {
                float v = rdt * Ah;
                v += __int_as_float(__builtin_amdgcn_update_dpp(0, __float_as_int(v), 0x111, 0xf, 0xf, true));
                v += __int_as_float(__builtin_amdgcn_update_dpp(0, __float_as_int(v), 0x112, 0xf, 0xf, true));
                v += __int_as_float(__builtin_amdgcn_update_dpp(0, __float_as_int(v), 0x114, 0xf, 0xf, true));
                v += __int_as_float(__builtin_amdgcn_update_dpp(0, __float_as_int(v), 0x118, 0xf, 0xf, true));
                v += __int_as_float(__builtin_amdgcn_update_dpp(0, __float_as_int(v), 0x142, 0xa, 0xf, false));
                v += __int_as_float(__builtin_amdgcn_update_dpp(0, __float_as_int(v), 0x143, 0xc, 0xf, false));
                const float tot = __int_as_float(__builtin_amdgcn_readlane(__float_as_int(v), 63));
                acum[lane] = v; dtv[lane] = rdt; wv[lane] = rdt * __expf(tot - v); eA[lane] = __expf(v);
                if (lane == 0) cdec[0] = __expf(tot);
            }
            __syncthreads();
            u32x4 rZ[2];
#pragma unroll
            for (int k = 0; k < 2; ++k) {
                const int id = tid + 256 * k, row = id >> 3, ch = id & 7;
                if (row < nvalid) rZ[k] = *(const u32x4*)(p.zbuf + (size_t)(row0 + c * 64 + row) * 2048 + hh * 64 + ch * 8);
                else rZ[k] = (u32x4){0u, 0u, 0u, 0u};
            }
            {
                bf16x8 cf[4];
#pragma unroll
                for (int s4 = 0; s4 < 4; ++s4) cf[s4] = *(const bf16x8*)(Ct + off_b(c16 + 16 * w, 4 * s4 + q4));
                float ai[4];
#pragma unroll
                for (int r = 0; r < 4; ++r) ai[r] = acum[16 * w + 4 * q4 + r];
#pragma unroll
                for (int tj = 0; tj < 4; ++tj) {
                    u32x2 mv; mv.x = 0u; mv.y = 0u;
                    if (tj <= w) {
                        f32x4 cb = (f32x4){0.f, 0.f, 0.f, 0.f};
#pragma unroll
                        for (int s4 = 0; s4 < 4; ++s4) {
                            const bf16x8 bfr = *(const bf16x8*)(Bt + off_b(c16 + 16 * tj, 4 * s4 + q4));
                            cb = __builtin_amdgcn_mfma_f32_16x16x32_bf16(cf[s4], bfr, cb, 0, 0, 0);
                        }
                        const int j = 16 * tj + c16;
                        const float aj = acum[j], dj = dtv[j];
                        float m[4];
#pragma unroll
                        for (int r = 0; r < 4; ++r) { const int i = 16 * w + 4 * q4 + r; m[r] = (j <= i) ? cb[r] * __expf(ai[r] - aj) * dj : 0.f; }
                        mv.x = pk2(m[0], m[1]); mv.y = pk2(m[2], m[3]);
                    }
                    *(u32x2*)(Mt + (16 * tj + c16) * SSD_MS + (16 * w + 4 * q4) * 2) = mv;
                }
            }
            f32x4 yacc[4];
#pragma unroll
            for (int it = 0; it < 4; ++it) yacc[it] = (f32x4){0.f, 0.f, 0.f, 0.f};
#pragma unroll
            for (int kp = 0; kp < 4; ++kp) {
                u32x4 sb;
                sb.x = pk2_sw(sT[2 * kp].x, sT[2 * kp].y); sb.y = pk2_sw(sT[2 * kp].z, sT[2 * kp].w); sb.z = pk2_sw(sT[2 * kp + 1].x, sT[2 * kp + 1].y); sb.w = pk2_sw(sT[2 * kp + 1].z, sT[2 * kp + 1].w);
                const unsigned n0 = 32 * kp + 4 * q4, n1 = n0 + 16;
#pragma unroll
                for (int it = 0; it < 4; ++it) {
                    const unsigned row = 16 * it + c16;
                    const u32x2 lo = *(const u32x2*)(Ct + off_b(row, n0 >> 3) + 8 * ((n0 >> 2) & 1)), hi = *(const u32x2*)(Ct + off_b(row, n1 >> 3) + 8 * ((n1 >> 2) & 1));
                    yacc[it] = __builtin_amdgcn_mfma_f32_16x16x32_bf16(__builtin_bit_cast(bf16x8, sb), frag8(lo, hi), yacc[it], 0, 0, 0);
                }
            }
#pragma unroll
            for (int it = 0; it < 4; ++it) yacc[it] *= eA[16 * it + c16];
#pragma unroll
            for (int k = 0; k < 2; ++k) { const unsigned id = tid + 256 * k, row = id >> 3, ch = id & 7; *(u32x4*)(Zt + row * SSD_XS + ch * 16) = rZ[k]; }
            __syncthreads();
            if (c + 1 < nchunks) load_chunk(c + 1);
            bf16x8 xf[2];
            {
                unsigned ax[4];
#pragma unroll
                for (int ks = 0; ks < 2; ++ks)
#pragma unroll
                    for (int t = 0; t < 2; ++t) ax[ks * 2 + t] = lbase + SSD_XT + (32u * ks + 8u * g + 4u * t + tq) * SSD_XS + (16u * w + 4u * tp) * 2u;
                u32x2 dx[4]; tr_read4(dx, ax);
                xf[0] = frag8(dx[0], dx[1]); xf[1] = frag8(dx[2], dx[3]);
            }
#pragma unroll
            for (int ih = 0; ih < 2; ++ih) {
                unsigned am[8];
#pragma unroll
                for (int ii = 0; ii < 2; ++ii)
#pragma unroll
                    for (int ks = 0; ks < 2; ++ks)
#pragma unroll
                        for (int t = 0; t < 2; ++t) am[(ii * 2 + ks) * 2 + t] = lbase + SSD_MT + (32u * ks + 8u * g + 4u * t + tq) * SSD_MS + (16u * (2 * ih + ii) + 4u * tp) * 2u;
                u32x2 dm[8]; tr_read8(dm, am);
#pragma unroll
                for (int ii = 0; ii < 2; ++ii)
#pragma unroll
                    for (int ks = 0; ks < 2; ++ks)
                        yacc[2 * ih + ii] = __builtin_amdgcn_mfma_f32_16x16x32_bf16(xf[ks], frag8(dm[(ii * 2 + ks) * 2], dm[(ii * 2 + ks) * 2 + 1]), yacc[2 * ih + ii], 0, 0, 0);
            }
#pragma unroll
            for (int it = 0; it < 4; ++it) {
                const int i = 16 * it + c16, pc0 = 16 * w + 4 * q4;
                const u32x2 x4 = *(const u32x2*)(Xt + i * SSD_XS + pc0 * 2), z4 = *(const u32x2*)(Zt + i * SSD_XS + pc0 * 2);
                const float v0 = (yacc[it].x + dsk * bf_lo(x4.x)) * silu_f(bf_lo(z4.x)), v1 = (yacc[it].y + dsk * bf_hi(x4.x)) * silu_f(bf_hi(z4.x));
                const float v2 = (yacc[it].z + dsk * bf_lo(x4.y)) * silu_f(bf_lo(z4.y)), v3 = (yacc[it].w + dsk * bf_hi(x4.y)) * silu_f(bf_hi(z4.y));
                if (i < nvalid) { u32x2 o; o.x = pk2(v0, v1); o.y = pk2(v2, v3); *(u32x2*)(p.bufA + (size_t)(row0 + c * 64 + i) * 2048 + hh * 64 + pc0) = o; }
                const float ssr = xor32_sum(xor16_sum((v0 * v0 + v1 * v1) + (v2 * v2 + v3 * v3)));
                if (q4 == 0) ssql[w * 64 + i] = ssr;
            }
            {
                bf16x8 x2f[2];
#pragma unroll
                for (int ks = 0; ks < 2; ++ks) {
                    const f32x4 w0 = *(const f32x4*)(wv + 32 * ks + 8 * g), w1 = *(const f32x4*)(wv + 32 * ks + 8 * g + 4);
                    const u32x4 u = __builtin_bit_cast(u32x4, xf[ks]);
                    u32x4 o;
                    o.x = pk2(bf_lo(u.x) * w0.x, bf_hi(u.x) * w0.y); o.y = pk2(bf_lo(u.y) * w0.z, bf_hi(u.y) * w0.w);
                    o.z = pk2(bf_lo(u.z) * w1.x, bf_hi(u.z) * w1.y); o.w = pk2(bf_lo(u.w) * w1.z, bf_hi(u.w) * w1.w);
                    x2f[ks] = __builtin_bit_cast(bf16x8, o);
                }
                const float cd = cdec[0];
#pragma unroll
                for (int nq = 0; nq < 4; ++nq) {
                    unsigned ab[8];
#pragma unroll
                    for (int ii = 0; ii < 2; ++ii)
#pragma unroll
                        for (int ks = 0; ks < 2; ++ks)
#pragma unroll
                            for (int t = 0; t < 2; ++t) ab[(ii * 2 + ks) * 2 + t] = lbase + off_b(32u * ks + 8u * g + 4u * t + tq, 2u * (2u * nq + ii) + (tp >> 1)) + 8u * (tp & 1u);
                    u32x2 db[8]; tr_read8(db, ab);
#pragma unroll
                    for (int ii = 0; ii < 2; ++ii) {
                        f32x4 acc = sT[2 * nq + ii] * cd;
#pragma unroll
                        for (int ks = 0; ks < 2; ++ks) acc = __builtin_amdgcn_mfma_f32_16x16x32_bf16(frag8(db[(ii * 2 + ks) * 2], db[(ii * 2 + ks) * 2 + 1]), x2f[ks], acc, 0, 0, 0);
                        sT[2 * nq + ii] = acc;
                    }
                }
            }
            __syncthreads();
            if (tid < 64 && tid < nvalid) p.ssq_y[(size_t)(row0 + c * 64 + tid) * 32 + hh] = (ssql[tid] + ssql[64 + tid]) + (ssql[128 + tid] + ssql[192 + tid]);
        }
#pragma unroll
        for (int nt = 0; nt < 8; ++nt) *(f32x4*)(so + (size_t)(16 * w + c16) * 128 + 16 * nt + 4 * q4) = sT[nt];
    }
    if (split) { if (ssd_bid >= 256) { if (l == 0) { convert_transposes(p, smem, 1, N_TJOBS, ssd_bid - 256, ssd_G - 256); convert_plain(p, (size_t)(ssd_bid - 256) * NTHREADS + tid, (size_t)(ssd_G - 256) * NTHREADS); }
                                       convert_tables(p, 2 * l, 2, (size_t)(ssd_bid - 256) * NTHREADS + tid, (size_t)(ssd_G - 256) * NTHREADS); } }
    else { if (l == 0) { convert_transposes(p, smem, 1, N_TJOBS, ssd_bid, ssd_G); convert_plain(p, (size_t)ssd_bid * NTHREADS + tid, (size_t)ssd_G * NTHREADS); }
           convert_tables(p, 2 * l, 2, (size_t)ssd_bid * NTHREADS + tid, (size_t)ssd_G * NTHREADS); }
}

#define AT_V 24576u
#define AT_VS 144u
__device__ __forceinline__ void phase_attn(const Params& p, int j, char* smem) {
    const int tid = TIDX, lane = tid & 63, w = p.wv, q4 = lane >> 4, c16 = lane & 15;
    const unsigned g = lane >> 4, tq = (lane & 15) >> 2, tp = lane & 3;
    const unsigned lbase = (unsigned)(size_t)smem;
    const bf16_t* qb = p.bufB;
    bf16_t* ob = p.bufB + (size_t)T_ALL * 1024;
    for (int item = BIDX; item < 1024 + 128; item += gridDim.x) {
        const bool prompt = item < 1024;
        int b, c = 0, kvh, qrow0, nqt, klo, khi;
        if (prompt) { b = item >> 7; c = (item >> 2) & 31; kvh = item & 3; qrow0 = b * 2048 + c * 64; nqt = 4; klo = c >= 2 ? 0 : (2 - c) * 64; khi = 192; }
        else { const int s = item - 1024; b = s >> 2; kvh = s & 3; qrow0 = T_P + b * 16; nqt = 1; klo = 0; khi = 144; }
        __syncthreads();
#pragma unroll
        for (int hb = 0; hb < 2; ++hb) {
            f32x4 kq[6], vq[6];
#pragma unroll
            for (int i2 = 0; i2 < 6; ++i2) {
                const int id = tid + 256 * (6 * hb + i2), row = id >> 4, cq = id & 15, rc = min(max(row, klo), khi - 1);
                const float* kp_kv = p.kv + (size_t)(prompt ? b * 2048 + (c - 2) * 64 + rc : T_P + b * 16 + max(rc - 128, 0)) * 512 + kvh * 64;
                const size_t co = ((size_t)(b * 128 + min(rc, 127)) * 4 + kvh) * 64;
                const bool from_cache = !prompt && rc < 128;
                const float* kp = from_cache ? p.cache_k + co : kp_kv;
                const float* vp = from_cache ? p.cache_v + co : kp_kv + 256;
                kq[i2] = *(const f32x4*)(kp + cq * 4); vq[i2] = *(const f32x4*)(vp + cq * 4);
            }
#pragma unroll
            for (int i2 = 0; i2 < 6; ++i2) {
                const int id = tid + 256 * (6 * hb + i2), row = id >> 4, cq = id & 15;
                const bool ok = row >= klo && row < khi;
                const f32x4 z = (f32x4){0.f, 0.f, 0.f, 0.f}, kx = ok ? kq[i2] : z, vx = ok ? vq[i2] : z;
                u32x2 kb, vb; kb.x = pk2(kx.x, kx.y); kb.y = pk2(kx.z, kx.w); vb.x = pk2(vx.x, vx.y); vb.y = pk2(vx.z, vx.w);
                *(u32x2*)(smem + row * 128 + ((((cq >> 1) ^ ((row >> 1) & 7))) << 4) + (cq & 1) * 8) = kb;
                *(u32x2*)(smem + AT_V + row * AT_VS + cq * 8) = vb;
            }
        }
        __syncthreads();
        const int hq = kvh * 4 + w;
        const float sink = p.a_sinks[j * 16 + hq];
        for (int qt = 0; qt < nqt; ++qt) {
            const bf16_t* qp = qb + (size_t)(qrow0 + 16 * qt + c16) * 1024 + hq * 64 + 8 * q4;
            const bf16x8 qf0 = *(const bf16x8*)qp, qf1 = *(const bf16x8*)(qp + 32);
            f32x4 sacc[12];
#pragma unroll
            for (int kt = 0; kt < 12; ++kt) {
                const int r = 16 * kt + c16;
                const bf16x8 kf0 = *(const bf16x8*)(smem + r * 128 + ((q4 ^ ((r >> 1) & 7)) << 4));
                const bf16x8 kf1 = *(const bf16x8*)(smem + r * 128 + (((4 + q4) ^ ((r >> 1) & 7)) << 4));
                f32x4 acc = (f32x4){0.f, 0.f, 0.f, 0.f};
                acc = __builtin_amdgcn_mfma_f32_16x16x32_bf16(kf0, qf0, acc, 0, 0, 0);
                acc = __builtin_amdgcn_mfma_f32_16x16x32_bf16(kf1, qf1, acc, 0, 0, 0);
                sacc[kt] = acc;
            }
            float mx = sink;
#pragma unroll
            for (int kt = 0; kt < 12; ++kt)
#pragma unroll
                for (int r = 0; r < 4; ++r) {
                    const int key = 16 * kt + 4 * q4 + r;
                    const float v = (key >= klo && key < khi) ? sacc[kt][r] * 0.125f : -INFINITY;
                    sacc[kt][r] = v; mx = fmaxf(mx, v);
                }
            mx = xor32_max(xor16_max(mx));
            float lsum = 0.f;
#pragma unroll
            for (int kt = 0; kt < 12; ++kt)
#pragma unroll
                for (int r = 0; r < 4; ++r) { const float pe = __expf(sacc[kt][r] - mx); sacc[kt][r] = pe; lsum += pe; }
            lsum = xor32_sum(xor16_sum(lsum));
            lsum += __expf(sink - mx);
            const float inv = 1.f / lsum;
            bf16x8 pf[6];
#pragma unroll
            for (int kp = 0; kp < 6; ++kp) {
                u32x4 u; u.x = pk2(sacc[2 * kp][0], sacc[2 * kp][1]); u.y = pk2(sacc[2 * kp][2], sacc[2 * kp][3]);
                u.z = pk2(sacc[2 * kp + 1][0], sacc[2 * kp + 1][1]); u.w = pk2(sacc[2 * kp + 1][2], sacc[2 * kp + 1][3]);
                pf[kp] = __builtin_bit_cast(bf16x8, u);
            }
#pragma unroll
            for (int dt = 0; dt < 4; ++dt) {
                unsigned a8[8], a4[4];
#pragma unroll
                for (int kp = 0; kp < 4; ++kp) {
                    a8[2 * kp] = lbase + AT_V + (32u * kp + 4u * g + tq) * AT_VS + (16u * dt + 4u * tp) * 2u;
                    a8[2 * kp + 1] = lbase + AT_V + (32u * kp + 16u + 4u * g + tq) * AT_VS + (16u * dt + 4u * tp) * 2u;
                }
#pragma unroll
                for (int kp = 4; kp < 6; ++kp) {
                    a4[2 * (kp - 4)] = lbase + AT_V + (32u * kp + 4u * g + tq) * AT_VS + (16u * dt + 4u * tp) * 2u;
                    a4[2 * (kp - 4) + 1] = lbase + AT_V + (32u * kp + 16u + 4u * g + tq) * AT_VS + (16u * dt + 4u * tp) * 2u;
                }
                u32x2 d8[8], d4[4]; tr_read8(d8, a8); tr_read4(d4, a4);
                f32x4 oacc = (f32x4){0.f, 0.f, 0.f, 0.f};
#pragma unroll
                for (int kp = 0; kp < 4; ++kp) oacc = __builtin_amdgcn_mfma_f32_16x16x32_bf16(frag8(d8[2 * kp], d8[2 * kp + 1]), pf[kp], oacc, 0, 0, 0);
#pragma unroll
                for (int kp = 4; kp < 6; ++kp) oacc = __builtin_amdgcn_mfma_f32_16x16x32_bf16(frag8(d4[2 * (kp - 4)], d4[2 * (kp - 4) + 1]), pf[kp], oacc, 0, 0, 0);
                u32x2 o; o.x = pk2(oacc.x * inv, oacc.y * inv); o.y = pk2(oacc.z * inv, oacc.w * inv);
                *(u32x2*)(ob + (size_t)(qrow0 + 16 * qt + c16) * 1024 + hq * 64 + 16 * dt + 4 * q4) = o;
            }
        }
    }
}

__device__ __forceinline__ void phase_kvwin(const Params& p) {
    const size_t gtid = (size_t)BIDX * NTHREADS + TIDX, gstride = (size_t)gridDim.x * NTHREADS;
    for (size_t i4 = gtid; i4 < (size_t)8 * 128 * 64; i4 += gstride) {
        const size_t i = i4 * 4; const int b = (int)(i >> 15), r = (int)(i >> 8) & 127, c = (int)(i & 255);
        const float* src = p.kv + (size_t)(b * 2048 + 1920 + r) * 512 + c;
        const f32x4 kk = *(const f32x4*)src, vv = *(const f32x4*)(src + 256);
        *(f32x4*)(p.out + OFF_PR_K + i) = kk; *(f32x4*)(p.out + OFF_PR_V + i) = vv;
    }
    for (size_t i4 = gtid; i4 < (size_t)32 * 128 * 64; i4 += gstride) {
        const size_t i = i4 * 4; const int b = (int)(i >> 15), r = (int)(i >> 8) & 127, c = (int)(i & 255);
        const bool fc = r < 112;
        const size_t co = ((size_t)b * 128 + min(r + 16, 127)) * 256 + c;
        const float* srck = p.kv + (size_t)(T_P + b * 16 + max(r - 112, 0)) * 512 + c;
        const float* kp = fc ? p.cache_k + co : srck;
        const float* vp = fc ? p.cache_v + co : srck + 256;
        const f32x4 kk = *(const f32x4*)kp, vv = *(const f32x4*)vp;
        *(f32x4*)(p.out + OFF_SM_K + i) = kk; *(f32x4*)(p.out + OFF_SM_V + i) = vv;
    }
}

#define TK_CE(a, i, j) { const float hi_ = fmaxf(a[i], a[j]), lo_ = fminf(a[i], a[j]); a[i] = hi_; a[j] = lo_; }
__device__ __forceinline__ void sort16_desc(float (&a)[16]) { TK_CE(a,0,1) TK_CE(a,2,3) TK_CE(a,0,2) TK_CE(a,1,3) TK_CE(a,1,2) TK_CE(a,4,5) TK_CE(a,6,7) TK_CE(a,4,6) TK_CE(a,5,7) TK_CE(a,5,6) TK_CE(a,0,4) TK_CE(a,2,6) TK_CE(a,2,4) TK_CE(a,1,5) TK_CE(a,3,7) TK_CE(a,3,5) TK_CE(a,1,2) TK_CE(a,3,4) TK_CE(a,5,6) TK_CE(a,8,9) TK_CE(a,10,11) TK_CE(a,8,10) TK_CE(a,9,11) TK_CE(a,9,10) TK_CE(a,12,13) TK_CE(a,14,15) TK_CE(a,12,14) TK_CE(a,13,15) TK_CE(a,13,14) TK_CE(a,8,12) TK_CE(a,10,14) TK_CE(a,10,12) TK_CE(a,9,13) TK_CE(a,11,15) TK_CE(a,11,13) TK_CE(a,9,10) TK_CE(a,11,12) TK_CE(a,13,14) TK_CE(a,0,8) TK_CE(a,4,12) TK_CE(a,4,8) TK_CE(a,2,10) TK_CE(a,6,14) TK_CE(a,6,10) TK_CE(a,2,4) TK_CE(a,6,8) TK_CE(a,10,12) TK_CE(a,1,9) TK_CE(a,5,13) TK_CE(a,5,9) TK_CE(a,3,11) TK_CE(a,7,15) TK_CE(a,7,11) TK_CE(a,3,5) TK_CE(a,7,9) TK_CE(a,11,13) TK_CE(a,1,2) TK_CE(a,3,4) TK_CE(a,5,6) TK_CE(a,7,8) TK_CE(a,9,10) TK_CE(a,11,12) TK_CE(a,13,14) }
__device__ __forceinline__ void bitonic16_desc(float (&a)[16]) { TK_CE(a,0,8) TK_CE(a,1,9) TK_CE(a,2,10) TK_CE(a,3,11) TK_CE(a,4,12) TK_CE(a,5,13) TK_CE(a,6,14) TK_CE(a,7,15) TK_CE(a,0,4) TK_CE(a,1,5) TK_CE(a,2,6) TK_CE(a,3,7) TK_CE(a,8,12) TK_CE(a,9,13) TK_CE(a,10,14) TK_CE(a,11,15) TK_CE(a,0,2) TK_CE(a,1,3) TK_CE(a,4,6) TK_CE(a,5,7) TK_CE(a,8,10) TK_CE(a,9,11) TK_CE(a,12,14) TK_CE(a,13,15) TK_CE(a,0,1) TK_CE(a,2,3) TK_CE(a,4,5) TK_CE(a,6,7) TK_CE(a,8,9) TK_CE(a,10,11) TK_CE(a,12,13) TK_CE(a,14,15) }
__device__ __forceinline__ void merge_top16(float (&a)[16], const float (&b)[16]) {
#pragma unroll
    for (int i = 0; i < 16; ++i) a[i] = fmaxf(a[i], b[15 - i]);
    bitonic16_desc(a);
}
__device__ __forceinline__ void ins16(float (&top)[16], float x) {
#pragma unroll
    for (int k = 0; k < 16; ++k) { const float hi = fmaxf(top[k], x); x = fminf(top[k], x); top[k] = hi; }
}
__device__ __forceinline__ void tk_load16(float (&k)[16], const bf16_t* s, int g) {
    const u32x4 a = *(const u32x4*)(s + 16 * g), b = *(const u32x4*)(s + 16 * g + 8);
    const unsigned u[8] = {a.x, a.y, a.z, a.w, b.x, b.y, b.z, b.w};
#pragma unroll
    for (int i = 0; i < 8; ++i) {
        k[2 * i] = __uint_as_float((u[i] << 16) | (unsigned)(16 * g + 2 * i));
        k[2 * i + 1] = __uint_as_float((u[i] & 0xffff0000u) | (unsigned)(16 * g + 2 * i + 1));
    }
}
__device__ __forceinline__ void tk_unpack16(float (&k)[16], const u32x4& a, const u32x4& b, int g) {
    const unsigned u[8] = {a.x, a.y, a.z, a.w, b.x, b.y, b.z, b.w};
#pragma unroll
    for (int i = 0; i < 8; ++i) {
        k[2 * i] = __uint_as_float((u[i] << 16) | (unsigned)(16 * g + 2 * i));
        k[2 * i + 1] = __uint_as_float((u[i] & 0xffff0000u) | (unsigned)(16 * g + 2 * i + 1));
    }
}
__device__ __forceinline__ void tk_top16_of_128(float (&acc)[16], const bf16_t* s) {
    u32x4 raw[16];
#pragma unroll
    for (int i = 0; i < 16; ++i) raw[i] = *(const u32x4*)(s + 8 * i);
    __builtin_amdgcn_sched_barrier(0);
    tk_unpack16(acc, raw[0], raw[1], 0); sort16_desc(acc);
#pragma unroll
    for (int g = 1; g < 8; ++g) { float grp[16]; tk_unpack16(grp, raw[2 * g], raw[2 * g + 1], g); sort16_desc(grp); merge_top16(acc, grp); }
}
__device__ __forceinline__ float tk_cand(const float (&t1)[16], const float (&t2)[16], int i, int j) {
    const float v = __uint_as_float(__float_as_uint(t1[i]) & ~127u) + __uint_as_float(__float_as_uint(t2[j]) & ~127u);
    return __uint_as_float((__float_as_uint(v) & ~255u) | (unsigned)(i * 16 + j));
}
__device__ __forceinline__ void phase_topk(const Params& p, char* smem) {
    const int tid = TIDX;
    const size_t gtid = (size_t)BIDX * NTHREADS + tid, gstride = (size_t)gridDim.x * NTHREADS;
    const bf16_t* sc = (const bf16_t*)p.ybuf;
    unsigned char* myl = (unsigned char*)smem + tid * 36;
    for (size_t row = gtid; row < (size_t)T_ALL * 8; row += gstride) {
        const bf16_t* s = sc + row * 256;
        float t1[16], t2[16];
        tk_top16_of_128(t1, s);
        tk_top16_of_128(t2, s + 128);
#pragma unroll
        for (int q = 0; q < 4; ++q) {
            *(unsigned*)(myl + 4 * q) = (__float_as_uint(t1[4 * q]) & 127u) | ((__float_as_uint(t1[4 * q + 1]) & 127u) << 8) | ((__float_as_uint(t1[4 * q + 2]) & 127u) << 16) | ((__float_as_uint(t1[4 * q + 3]) & 127u) << 24);
            *(unsigned*)(myl + 16 + 4 * q) = (__float_as_uint(t2[4 * q]) & 127u) | ((__float_as_uint(t2[4 * q + 1]) & 127u) << 8) | ((__float_as_uint(t2[4 * q + 2]) & 127u) << 16) | ((__float_as_uint(t2[4 * q + 3]) & 127u) << 24);
        }
        float acc[16], grp[16];
#pragma unroll
        for (int j = 0; j < 16; ++j) acc[j] = tk_cand(t1, t2, 0, j);
        sort16_desc(acc);
        {
            int n = 0;
#pragma unroll
            for (int j = 0; j < 8; ++j) grp[n++] = tk_cand(t1, t2, 1, j);
#pragma unroll
            for (int j = 0; j < 5; ++j) grp[n++] = tk_cand(t1, t2, 2, j);
#pragma unroll
            for (int j = 0; j < 3; ++j) grp[n++] = tk_cand(t1, t2, 3, j);
            sort16_desc(grp); merge_top16(acc, grp);
        }
        {
            int n = 0;
            grp[n++] = tk_cand(t1, t2, 3, 3);
#pragma unroll
            for (int j = 0; j < 3; ++j) grp[n++] = tk_cand(t1, t2, 4, j);
#pragma unroll
            for (int i = 5; i < 8; ++i) { grp[n++] = tk_cand(t1, t2, i, 0); grp[n++] = tk_cand(t1, t2, i, 1); }
#pragma unroll
            for (int i = 8; i < 14; ++i) grp[n++] = tk_cand(t1, t2, i, 0);
            sort16_desc(grp); merge_top16(acc, grp);
        }
        ins16(acc, tk_cand(t1, t2, 14, 0));
        ins16(acc, tk_cand(t1, t2, 15, 0));
        float ex[16], sum = 0.f; int te[16];
        const float v0 = __uint_as_float(__float_as_uint(acc[0]) & ~255u);
#pragma unroll
        for (int k = 0; k < 16; ++k) {
            const unsigned kb = __float_as_uint(acc[k]);
            ex[k] = __expf(__uint_as_float(kb & ~255u) - v0); sum += ex[k];
            te[k] = (int)myl[(kb >> 4) & 15u] * 128 + (int)myl[16 + (kb & 15u)];
        }
        const float inv = 1.f / sum;
        const size_t tt = row >> 3; const int hh = (int)(row & 7);
        int* eo = p.eid + tt * 128 + 2 * hh; float* go = p.gate + tt * 128 + 2 * hh;
#pragma unroll
        for (int kk = 0; kk < 16; ++kk) { eo[(kk & 7) * 16 + (kk >> 3)] = te[kk]; go[(kk & 7) * 16 + (kk >> 3)] = ex[kk] * inv; }
    }
}

__device__ __forceinline__ void peer_load_e(int4 (&ev)[4], const int* eid, int t, int ex) {
    const char* q = (const char*)(eid + (size_t)t * 128);
#pragma unroll
    for (int i = 0; i < 4; ++i) ev[i] = *(const int4*)(q + (unsigned)(ex * 64 + 16 * i));
}
__device__ __forceinline__ void peer_load_r(u32x4 (&r)[16], const int4 (&ev)[4], const unsigned char* tab, unsigned pc) {
#pragma unroll
    for (int i = 0; i < 4; ++i) {
        r[4 * i + 0] = *(const u32x4*)(tab + (size_t)((unsigned)ev[i].x * 128u + pc)); r[4 * i + 1] = *(const u32x4*)(tab + (size_t)((unsigned)ev[i].y * 128u + pc));
        r[4 * i + 2] = *(const u32x4*)(tab + (size_t)((unsigned)ev[i].z * 128u + pc)); r[4 * i + 3] = *(const u32x4*)(tab + (size_t)((unsigned)ev[i].w * 128u + pc));
    }
}

__device__ __forceinline__ void g1_compute(const Params& p, const u32x4 (&r)[16], unsigned xr, int t, int s, int sub, int lane, char* xs) {
    const float x0 = bf_lo(xr), x1 = bf_hi(xr);
    float am = fmaxf(fabsf(x0), fabsf(x1));
    am = fmaxf(am, dpp_mov<0xB1>(am)); am = fmaxf(am, dpp_mov<0x4E>(am)); am = fmaxf(am, dpp_mov<0x141>(am)); am = fmaxf(am, dpp_mov<0x140>(am));
    am = xor32_max(xor16_max(am));
    am = fmaxf(am, 1e-20f);
    const float qs = 127.f / am;
    const int i0 = max(-127, min(127, __float2int_rn(x0 * qs))), i1 = max(-127, min(127, __float2int_rn(x1 * qs)));
    *(unsigned short*)(xs + 2 * lane) = (unsigned short)((i0 & 255) | ((i1 & 255) << 8));
    const u32x4 qv = *(const u32x4*)(xs + 16 * sub);
    const unsigned qx[4] = {qv.x, qv.y, qv.z, qv.w};
    int d[16];
#pragma unroll
    for (int g = 0; g < 16; ++g) {
        int acc = __builtin_amdgcn_sdot4((int)r[g].x, (int)qx[0], 0, false);
        acc = __builtin_amdgcn_sdot4((int)r[g].y, (int)qx[1], acc, false);
        acc = __builtin_amdgcn_sdot4((int)r[g].z, (int)qx[2], acc, false);
        acc = __builtin_amdgcn_sdot4((int)r[g].w, (int)qx[3], acc, false);
        d[g] = acc;
    }
    const bool b2 = (sub & 4) != 0, b1 = (sub & 2) != 0, b0 = (sub & 1) != 0;
    int n8[8], n4[4], n2[2];
#pragma unroll
    for (int i = 0; i < 8; ++i) { const int send = b2 ? d[i] : d[8 + i], keep = b2 ? d[8 + i] : d[i]; n8[i] = keep + dpp_movi<0x141>(send); }
#pragma unroll
    for (int i = 0; i < 4; ++i) { const int send = b1 ? n8[i] : n8[4 + i], keep = b1 ? n8[4 + i] : n8[i]; n4[i] = keep + dpp_movi<0x4E>(send); }
#pragma unroll
    for (int i = 0; i < 2; ++i) { const int send = b0 ? n4[i] : n4[2 + i], keep = b0 ? n4[2 + i] : n4[i]; n2[i] = keep + dpp_movi<0xB1>(send); }
    const float sc = am * (1.f / (127.f * 512.f));
    char* po = (char*)(p.partial + ((size_t)t * 8 + s) * 128);
    *(float*)(po + (unsigned)(4 * lane)) = (float)n2[0] * sc; *(float*)(po + (unsigned)(4 * lane + 256)) = (float)n2[1] * sc;
}
__device__ __forceinline__ void phase_g1(const Params& p, int l, char* smem) {
    const int tid = TIDX, lane = tid & 63, w = __builtin_amdgcn_readfirstlane(tid >> 6), bid = BIDX;
    const int nrank = gridDim.x >> 3;
    if (bid >= nrank * 8) return;
    const int s = bid & 7, rank = bid >> 3, sub = lane & 7, ex = lane >> 3, stride = nrank * 4;
    const unsigned char* ut = p.u8 + ((size_t)l * 8 + s) * 16384 * 128;
    const unsigned pc = 16u * sub;
    const bf16_t* xb = p.xn2 + 128 * s; const unsigned xo = 4u * lane;
    char* xs = smem + 128 * w;
    int t = rank * 4 + w;
    if (t >= T_ALL) return;
    int4 e0[4], e1[4]; u32x4 rA[16], rB[16]; unsigned xA, xB;
    peer_load_e(e0, p.eid, t, ex); peer_load_e(e1, p.eid, min(t + stride, T_ALL - 1), ex);
    peer_load_r(rA, e0, ut, pc);
    xA = *(const unsigned*)((const char*)(xb + (size_t)t * DM) + xo);
    for (;;) {
        {
            const int tn = t + stride, tc = min(tn, T_ALL - 1), tcc = min(tn + stride, T_ALL - 1);
            peer_load_e(e0, p.eid, tcc, ex);
            peer_load_r(rB, e1, ut, pc); xB = *(const unsigned*)((const char*)(xb + (size_t)tc * DM) + xo);
            __builtin_amdgcn_sched_barrier(0);
            g1_compute(p, rA, xA, t, s, sub, lane, xs);
            t = tn; if (t >= T_ALL) break;
        }
        {
            const int tn = t + stride, tc = min(tn, T_ALL - 1), tcc = min(tn + stride, T_ALL - 1);
            peer_load_e(e1, p.eid, tcc, ex);
            peer_load_r(rA, e0, ut, pc); xA = *(const unsigned*)((const char*)(xb + (size_t)tc * DM) + xo);
            __builtin_amdgcn_sched_barrier(0);
            g1_compute(p, rB, xB, t, s, sub, lane, xs);
            t = tn; if (t >= T_ALL) break;
        }
    }
}

__device__ __forceinline__ void phase_w(const Params& p) {
    const int lane = TIDX & 63, gw = BIDX * 4 + p.wv, nw = gridDim.x * 4;
    for (int t0 = gw; t0 < T_ALL; t0 += 2 * nw) {
        float sm[2][2], gt[2][2], sq[2];
        f32x4 qv[2][4]; float pv[2][2][8];
#pragma unroll
        for (int u = 0; u < 2; ++u) {
            const int t = min(t0 + u * nw, T_ALL - 1);
#pragma unroll
            for (int q = 0; q < 4; ++q) qv[u][q] = *(const f32x4*)(p.ssq_h2 + (size_t)t * 16 + q * 4);
#pragma unroll
            for (int j = 0; j < 2; ++j) {
                const int pos = 2 * lane + j, ex = pos >> 4, g = pos & 15, pslot = (g & 1) * 64 + ex * 8 + (g >> 1);
#pragma unroll
                for (int s2 = 0; s2 < 8; ++s2) pv[u][j][s2] = p.partial[((size_t)t * 8 + s2) * 128 + pslot];
                gt[u][j] = p.gate[(size_t)t * 128 + pos];
            }
        }
        __builtin_amdgcn_sched_barrier(0);
#pragma unroll
        for (int u = 0; u < 2; ++u) {
            float q4s = 0.f;
#pragma unroll
            for (int q = 0; q < 4; ++q) q4s += (qv[u][q].x + qv[u][q].y) + (qv[u][q].z + qv[u][q].w);
            sq[u] = q4s;
#pragma unroll
            for (int j = 0; j < 2; ++j) sm[u][j] = ((pv[u][j][0] + pv[u][j][1]) + (pv[u][j][2] + pv[u][j][3])) + ((pv[u][j][4] + pv[u][j][5]) + (pv[u][j][6] + pv[u][j][7]));
        }
#pragma unroll
        for (int u = 0; u < 2; ++u) {
            const int t = t0 + u * nw;
            if (t < T_ALL) {
                const float rr = rsqrtf(sq[u] * (1.f / 1024.f) + 1e-6f);
                const float w0 = gt[u][0] * gelu_tanh(sm[u][0] * rr), w1 = gt[u][1] * gelu_tanh(sm[u][1] * rr);
                float wm = fmaxf(fabsf(w0), fabsf(w1));
                wm = fmaxf(wm, dpp_mov<0xB1>(wm)); wm = fmaxf(wm, dpp_mov<0x4E>(wm)); wm = fmaxf(wm, dpp_mov<0x141>(wm)); wm = fmaxf(wm, dpp_mov<0x140>(wm));
                wm = xor32_max(xor16_max(wm));
                wm = fmaxf(wm, 1e-30f);
                const float qs = 127.f / wm;
                const int q0 = max(-127, min(127, __float2int_rn(w0 * qs))), q1 = max(-127, min(127, __float2int_rn(w1 * qs)));
                *(unsigned short*)(p.wq + (size_t)t * 128 + 2 * lane) = (unsigned short)((q0 & 255) | ((q1 & 255) << 8));
                if (lane == 0) p.wscale[t] = wm * (1.f / (127.f * 256.f));
            }
        }
    }
}

template <class Pre>
__device__ __forceinline__ void g2_compute(const Params& p, const u32x4 (&r)[16], const u32x4& wq, float wsc, const f32x2& hv, int t, int s, int sub, int lane, Pre&& pre) {
    int acc[16];
#pragma unroll
    for (int i = 0; i < 16; ++i) acc[i] = 0;
#pragma unroll
    for (int gq = 0; gq < 4; ++gq) {
        pre(gq);
        __builtin_amdgcn_sched_barrier(0);
        const int wp = (int)wq[gq];
#pragma unroll
        for (int i = 0; i < 4; ++i) {
            const unsigned a = r[4 * gq][i], b = r[4 * gq + 1][i], c = r[4 * gq + 2][i], d = r[4 * gq + 3][i];
            const unsigned ab_lo = __builtin_amdgcn_perm(b, a, 0x05010400u), ab_hi = __builtin_amdgcn_perm(b, a, 0x07030602u);
            const unsigned cd_lo = __builtin_amdgcn_perm(d, c, 0x05010400u), cd_hi = __builtin_amdgcn_perm(d, c, 0x07030602u);
            const unsigned t0 = __builtin_amdgcn_perm(cd_lo, ab_lo, 0x05040100u), t1 = __builtin_amdgcn_perm(cd_lo, ab_lo, 0x07060302u);
            const unsigned t2 = __builtin_amdgcn_perm(cd_hi, ab_hi, 0x05040100u), t3 = __builtin_amdgcn_perm(cd_hi, ab_hi, 0x07060302u);
            acc[4 * i + 0] = __builtin_amdgcn_sdot4((int)t0, wp, acc[4 * i + 0], false);
            acc[4 * i + 1] = __builtin_amdgcn_sdot4((int)t1, wp, acc[4 * i + 1], false);
            acc[4 * i + 2] = __builtin_amdgcn_sdot4((int)t2, wp, acc[4 * i + 2], false);
            acc[4 * i + 3] = __builtin_amdgcn_sdot4((int)t3, wp, acc[4 * i + 3], false);
        }
    }
    const bool b5 = (lane & 32) != 0, b4 = (lane & 16) != 0, b3 = (lane & 8) != 0;
    int n8[8], n4[4], n2[2];
#pragma unroll
    for (int i = 0; i < 8; ++i) { const auto r2 = __builtin_amdgcn_permlane32_swap((unsigned)acc[i], (unsigned)acc[8 + i], false, false); n8[i] = (int)(r2[0] + r2[1]); }
#pragma unroll
    for (int i = 0; i < 4; ++i) { const auto r2 = __builtin_amdgcn_permlane16_swap((unsigned)n8[i], (unsigned)n8[4 + i], false, false); n4[i] = (int)(r2[0] + r2[1]); }
#pragma unroll
    for (int i = 0; i < 2; ++i) { const int send = b3 ? n4[i] : n4[2 + i], keep = b3 ? n4[2 + i] : n4[i]; n2[i] = keep + dpp_movi<0x128>(send); }
    const int src = ((lane & 7) << 5) | ((lane >> 3) << 2);
    const int m0 = __builtin_amdgcn_ds_bpermute(src, n2[0]), m1 = __builtin_amdgcn_ds_bpermute(src, n2[1]);
    const size_t o = (size_t)t * DM + 128 * s;
    const f32x2 ho = hv + (f32x2){(float)m0 * wsc, (float)m1 * wsc};
    *(f32x2*)((char*)(p.h + o) + (unsigned)(8 * lane)) = ho;
    *(unsigned*)((char*)(p.xn + o) + (unsigned)(4 * lane)) = pk2(ho.x, ho.y);
    const float ss = wave_sum(ho.x * ho.x + ho.y * ho.y);
    if (lane == 0) p.ssq_h[(size_t)t * 8 + s] = ss;
}
__device__ __forceinline__ void phase_g2(const Params& p, int l, int mode) {
    const int tid = TIDX, lane = tid & 63, w = __builtin_amdgcn_readfirstlane(tid >> 6), bid = BIDX;
    const int nrank = gridDim.x >> 3;
    if (bid >= nrank * 8) return;
    const int s = bid & 7, rank = bid >> 3, sub = lane & 7, ex = lane >> 3, stride = nrank * 4;
    const unsigned char* vt = p.v8 + ((size_t)l * 8 + s) * 16384 * 128;
    const unsigned pc = 16u * sub;
    const float* hb = p.h2 + 128 * s; const unsigned ho8 = 8u * lane;
    const unsigned char* wb = p.wq; const unsigned wo = 16u * ex;
    int t = rank * 4 + w;
    if (t >= T_ALL) return;
    int4 e0[4], e1[4]; u32x4 rA[16], rB[16], wA, wB; f32x2 hA, hB; float sA, sB;
    peer_load_e(e0, p.eid, t, ex); peer_load_e(e1, p.eid, min(t + stride, T_ALL - 1), ex);
    if (mode != 1) peer_load_r(rA, e0, vt, pc);
    wA = *(const u32x4*)(wb + (size_t)t * 128 + wo); sA = p.wscale[t]; hA = *(const f32x2*)((const char*)(hb + (size_t)t * DM) + ho8);
    for (;;) {
        {
            const int tn = t + stride, tc = min(tn, T_ALL - 1), tcc = min(tn + stride, T_ALL - 1);
            peer_load_e(e0, p.eid, tcc, ex);
            wB = *(const u32x4*)(wb + (size_t)tc * 128 + wo); sB = p.wscale[tc]; hB = *(const f32x2*)((const char*)(hb + (size_t)tc * DM) + ho8);
            __builtin_amdgcn_sched_barrier(0);
            if (mode != 2) g2_compute(p, rA, wA, sA, hA, t, s, sub, lane, [&](int gq) {
                rB[4 * gq + 0] = *(const u32x4*)(vt + (size_t)((unsigned)e1[gq].x * 128u + pc)); rB[4 * gq + 1] = *(const u32x4*)(vt + (size_t)((unsigned)e1[gq].y * 128u + pc));
                rB[4 * gq + 2] = *(const u32x4*)(vt + (size_t)((unsigned)e1[gq].z * 128u + pc)); rB[4 * gq + 3] = *(const u32x4*)(vt + (size_t)((unsigned)e1[gq].w * 128u + pc)); }); else { unsigned x = 0; _Pragma("unroll") for (int i = 0; i < 16; ++i) x |= rA[i].x | rA[i].y | rA[i].z | rA[i].w; asm volatile("" :: "v"(x), "v"(wA), "v"(sA), "v"(hA)); }
            t = tn; if (t >= T_ALL) break;
        }
        {
            const int tn = t + stride, tc = min(tn, T_ALL - 1), tcc = min(tn + stride, T_ALL - 1);
            peer_load_e(e1, p.eid, tcc, ex);
            wA = *(const u32x4*)(wb + (size_t)tc * 128 + wo); sA = p.wscale[tc]; hA = *(const f32x2*)((const char*)(hb + (size_t)tc * DM) + ho8);
            __builtin_amdgcn_sched_barrier(0);
            if (mode != 2) g2_compute(p, rB, wB, sB, hB, t, s, sub, lane, [&](int gq) {
                rA[4 * gq + 0] = *(const u32x4*)(vt + (size_t)((unsigned)e0[gq].x * 128u + pc)); rA[4 * gq + 1] = *(const u32x4*)(vt + (size_t)((unsigned)e0[gq].y * 128u + pc));
                rA[4 * gq + 2] = *(const u32x4*)(vt + (size_t)((unsigned)e0[gq].z * 128u + pc)); rA[4 * gq + 3] = *(const u32x4*)(vt + (size_t)((unsigned)e0[gq].w * 128u + pc)); }); else { unsigned x = 0; _Pragma("unroll") for (int i = 0; i < 16; ++i) x |= rB[i].x | rB[i].y | rB[i].z | rB[i].w; asm volatile("" :: "v"(x), "v"(wB), "v"(sB), "v"(hB)); }
            t = tn; if (t >= T_ALL) break;
        }
    }
}

__device__ __forceinline__ void phase_final(const Params& p) {
    const int lane = TIDX & 63, gw = BIDX * 4 + p.wv, nw = gridDim.x * 4;
    f32x4 gv[4];
#pragma unroll
    for (int i = 0; i < 4; ++i) gv[i] = *(const f32x4*)(p.norm_final + i * 256 + lane * 4);
    for (int row0 = gw; row0 < T_ALL; row0 += 2 * nw) {
        f32x4 v[2][4];
#pragma unroll
        for (int u = 0; u < 2; ++u)
#pragma unroll
            for (int i = 0; i < 4; ++i) v[u][i] = *(const f32x4*)(p.h + (size_t)min(row0 + u * nw, T_ALL - 1) * DM + i * 256 + lane * 4);
#pragma unroll
        for (int u = 0; u < 2; ++u) {
            const int row = row0 + u * nw;
            float ss = 0.f;
#pragma unroll
            for (int i = 0; i < 4; ++i) ss += v[u][i].x * v[u][i].x + v[u][i].y * v[u][i].y + v[u][i].z * v[u][i].z + v[u][i].w * v[u][i].w;
            ss = wave_sum(ss);
            const float inv = rsqrtf(ss * (1.f / 1024.f) + 1e-6f);
            if (row < T_ALL) {
#pragma unroll
                for (int i = 0; i < 4; ++i) *(f32x4*)(p.out + OFF_Y + (size_t)row * DM + i * 256 + lane * 4) = v[u][i] * inv * gv[i];
            }
        }
    }
}

#define XB_TMO      128
#define XB_XCNT(j)  (256  + 64 * (j))
#define XB_XSUB(j)  (1280 + 64 * (j))
#define XB_XGEN(j)  (2304 + 64 * (j))
#define XB_TOP      3328
#define XB_TOPGEN   3392
#define XCD_BAR_WORDS 3456
#define XB_SPIN_CAP (1u << 20)
__device__ __forceinline__ unsigned xb_ld(unsigned* p)              { return __hip_atomic_load(p, __ATOMIC_RELAXED, __HIP_MEMORY_SCOPE_AGENT); }
__device__ __forceinline__ unsigned xb_add(unsigned* p, unsigned v) { return __hip_atomic_fetch_add(p, v, __ATOMIC_RELAXED, __HIP_MEMORY_SCOPE_AGENT); }
__device__ __forceinline__ unsigned xb_xcc_id() { return (unsigned)__builtin_amdgcn_s_getreg((3 << 11) | 20) & 0xFu; }
#define XB_SPIN(cond, bar) do { unsigned _sp = 0; while (cond) { __builtin_amdgcn_s_sleep(1); \
    if ((++_sp & 255u) == 0u) { if (xb_ld(&(bar)[XB_TMO])) break; if (_sp > XB_SPIN_CAP) { atomicAdd(&(bar)[XB_TMO], 1u); break; } } } } while (0)
struct XcdBarrier { unsigned* bar; unsigned x; volatile LAS unsigned* st; int wv; };
__device__ __forceinline__ XcdBarrier xcd_barrier_post(unsigned* bar, volatile LAS unsigned* st, int wv) {
    XcdBarrier b; b.bar = bar; b.x = xb_xcc_id(); b.st = st; b.wv = wv;
    if (lt(wv) == 0) (void)xb_add(&bar[XB_XCNT(b.x)], 1u);
    return b;
}
__device__ __forceinline__ void xcd_barrier_complete(unsigned* bar, unsigned x, unsigned& nloc, unsigned& nx) {
    const unsigned G = gridDim.x * gridDim.y * gridDim.z;
    unsigned sum, cnt, mine, sp = 0u;
    for (;;) {
        sum = 0u; cnt = 0u; mine = 0u;
#pragma unroll
        for (unsigned j = 0; j < 16; ++j) { const unsigned c = xb_ld(&bar[XB_XCNT(j)]); sum += c; cnt += (c > 0u) ? 1u : 0u; mine = (j == x) ? c : mine; }
        if (sum == G) break;
        __builtin_amdgcn_s_sleep(1);
        if ((++sp & 255u) == 0u) { if (xb_ld(&bar[XB_TMO])) break; if (sp > XB_SPIN_CAP) { atomicAdd(&bar[XB_TMO], 1u); break; } }
    }
    nloc = mine > 0u ? mine : 1u; nx = cnt > 0u ? cnt : 1u;
}
__device__ __forceinline__ void xcd_barrier(const XcdBarrier& b) {
    asm volatile("s_waitcnt vmcnt(0)" ::: "memory");
    __syncthreads();
    if (lt(b.wv) == 0) {
        unsigned* bar = b.bar;
        __builtin_amdgcn_s_waitcnt(0);
        unsigned nloc = b.st[0], nx = b.st[1];
        if (nloc == 0u) { xcd_barrier_complete(bar, b.x, nloc, nx); b.st[0] = nloc; b.st[1] = nx; }
        const unsigned old = xb_add(&bar[XB_XSUB(b.x)], 1u);
        const unsigned gen = old / nloc;
        if (old + 1u == (gen + 1u) * nloc) {
            __builtin_amdgcn_fence(__ATOMIC_RELEASE, "agent");
            asm volatile("s_waitcnt vmcnt(0)" ::: "memory");
            const unsigned og = xb_add(&bar[XB_TOP], 1u);
            const unsigned tg = og / nx;
            if (og + 1u == (tg + 1u) * nx) xb_add(&bar[XB_TOPGEN], 1u);
            else XB_SPIN(xb_ld(&bar[XB_TOPGEN]) == tg, bar);
            __builtin_amdgcn_fence(__ATOMIC_ACQUIRE, "agent");
            xb_add(&bar[XB_XGEN(b.x)], 1u);
            asm volatile("s_waitcnt vmcnt(0)" ::: "memory");
        } else {
            XB_SPIN(xb_ld(&bar[XB_XGEN(b.x)]) == gen, bar);
            __builtin_amdgcn_fence(__ATOMIC_ACQUIRE, "agent");
            asm volatile("s_waitcnt vmcnt(0)" ::: "memory");
        }
    }
    __syncthreads();
}

#define N_PHASES 37

__device__ __forceinline__ void phase_wfuse(const Params& p, char* smem) {
    const RowScale rs{nullptr, 0, 0.f};
    for (int id = BIDX; id < 512; id += gridDim.x) {
        const int l = id >> 7, hh = (id >> 3) & 15, mt = id & 7;
        EpiTransBf16 e{p.w_pq_t + ((size_t)l * 2048 + hh * 128) * 1024, 1024};
        gemm_tile<4>(p.wq_b + (size_t)l * 1024 * 2048 + hh * 128, 2048, p.subk + ((size_t)l * 2 + (hh & 1)) * 16384, 128, 128, mt * 128, 0, smem, e, rs, p.wv);
    }
}

#ifndef PROBE_G2_MODE
#define PROBE_G2_MODE 0
#endif
__device__ __forceinline__ void run_peer_phase(const Params& p, int l, int sub, char* smem, bool probe) {
    if (sub == 0) { EpiBf16<false> e{(bf16_t*)p.ybuf, 2048, nullptr}; RowScale rs{p.ssq_h2, 16, 1.f / 1024.f}; gemm_phase<6>(p.xn2, DM, p.w_pq_t + (size_t)l * 2048 * 1024, DM, 1024, T_ALL, 2048, smem, e, rs, p.wv); }
    else if (sub == 1) phase_topk(p, smem);
    else if (sub == 2) phase_g1(p, l, smem);
    else if (sub == 3) phase_w(p);
    else phase_g2(p, l, probe ? PROBE_G2_MODE : 0);
}

__device__ __forceinline__ void run_phase(const Params& p, int ph, char* smem, bool probe = false) {
    if (ph == 0) { phase_convert(p, smem); phase_embed(p); return; }
    if (ph == 1) return;
    if (ph == N_PHASES - 1) { phase_final(p); return; }
    const RowScale rs_h{p.ssq_h, 8, 1.f / 1024.f}, rs_none{nullptr, 0, 0.f};
    if (ph < 20) {
        const int l = (ph - 2) / 9, sub = (ph - 2) % 9;
        if (sub == 0) { EpiInProj e{p.zbuf, p.bufA, p.dtraw}; gemm_phase<6>(p.xn, DM, p.w_in_t + (size_t)l * 6272 * 1024, DM, 1024, T_ALL, 6272, smem, e, rs_h, p.wv); }
        else if (sub == 1) phase_conv(p, l);
        else if (sub == 2) phase_ssd(p, l, smem);
        else if (sub == 3) { EpiResidual<false> e{p.h, p.h2, p.xn2, p.ssq_h2, nullptr}; RowScale rs{p.ssq_y, 32, 1.f / 2048.f};
                             gemm_phase<3>(p.bufA, 2048, p.w_out_t + (size_t)l * 1024 * 2048, 2048, 2048, T_ALL, 1024, smem, e, rs, p.wv);
                             if (l == 0) phase_wfuse(p, smem); }
        else run_peer_phase(p, l, sub - 4, smem, probe);
        return;
    }
    const int j = (ph - 20) / 8, sub = (ph - 20) % 8, l = 2 + j;
    if (sub == 0) {
        { EpiBf16<true> e{p.bufB, 1024, p.a_b_q + (size_t)j * 1024}; gemm_phase<3>(p.xn, DM, p.w_aq_t + (size_t)j * 1024 * 1024, DM, 1024, T_ALL, 1024, smem, e, rs_h, p.wv); }
        if (j == 0) { EpiF32<true> e{p.kv, 512, 0, p.a_b_kv}; gemm_phase<3>(p.xn, DM, p.w_kv_t, DM, 1024, T_ALL, 512, smem, e, rs_h, p.wv); }
    }
    else if (sub == 1) { phase_attn(p, j, smem); if (j == 0) phase_kvwin(p); }
    else if (sub == 2) { EpiResidual<true> e{p.h, p.h2, p.xn2, p.ssq_h2, p.a_b_o + (size_t)j * 1024};
                         gemm_phase<3>(p.bufB + (size_t)T_ALL * 1024, 1024, p.w_ao_t + (size_t)j * 1024 * 1024, 1024, 1024, T_ALL, 1024, smem, e, rs_none, p.wv); }
    else run_peer_phase(p, l, sub - 3, smem, probe);
}

#ifndef PROBE_MASK
#define PROBE_MASK 0
#endif
__device__ __forceinline__ int phase_kind(int ph) {
    if (ph == 0) return 0;
    if (ph == 1) return 14;
    if (ph == N_PHASES - 1) return 13;
    if (ph < 20) return 1 + (ph - 2) % 9;
    const int sub = (ph - 20) % 8;
    return sub < 3 ? 10 + sub : 5 + (sub - 3);
}
__global__ void __launch_bounds__(NTHREADS, 2) mega(Params pk) {
    Params p = pk; p.wv = __builtin_amdgcn_readfirstlane((int)(threadIdx.x >> 6));
    extern __shared__ __attribute__((aligned(16))) char smem[];
    volatile LAS unsigned* st = (volatile LAS unsigned*)(smem + DYN_LDS_BYTES - 16);
    if (lt(p.wv) == 0) { st[0] = 0u; st[1] = 0u; }
    __syncthreads();
    XcdBarrier xb = xcd_barrier_post(p.bar, st, p.wv);
    for (int ph = p.ph_lo; ph < p.ph_hi; ++ph) {
#if PROBE_MASK
        if ((PROBE_MASK >> phase_kind(ph)) & 1) { run_phase(p, ph, smem, true); xcd_barrier(xb); }
#endif
        if (ph == 1) continue;
        run_phase(p, ph, smem);
        if (ph + 1 < p.ph_hi) {
            xcd_barrier(xb);
        }
    }
}

extern "C" void kernel_launch(void* const* d_in, const int* in_sizes, int n_in, void* d_out, int out_size, void* d_ws, size_t ws_size, hipStream_t stream) {
    Params p{};
    const float* const* in = (const float* const*)d_in;
    p.x_prompt = in[0]; p.x_sample = in[1]; p.state_ssm = in[2]; p.state_conv = in[3]; p.cache_k = in[4]; p.cache_v = in[5];
    p.norm_mix = in[6]; p.norm_ffn = in[7]; p.norm_kv = in[8]; p.norm_final = in[9];
    p.m_w_in = in[10]; p.m_conv_w = in[11]; p.m_conv_b = in[12]; p.m_dt_bias = in[13]; p.m_a_log = in[14]; p.m_d_skip = in[15]; p.m_norm = in[16]; p.m_w_out = in[17];
    p.a_w_kv = in[18]; p.a_b_kv = in[19]; p.a_w_q = in[20]; p.a_b_q = in[21]; p.a_sinks = in[22]; p.a_w_o = in[23]; p.a_b_o = in[24];
    p.p_w_q = in[25]; p.p_sub_k1 = in[26]; p.p_sub_k2 = in[27]; p.p_u = in[28]; p.p_v = in[29];
    p.out = (float*)d_out;
    char* w = (char*)d_ws; size_t off = 0;
    auto take = [&](size_t bytes) { char* r = w + off; off += (bytes + 255) & ~(size_t)255; return r; };
    p.bar = (unsigned*)take(65536);
    p.w_in_t = (bf16_t*)take((size_t)2 * 6272 * 1024 * 2);
    p.w_out_t = (bf16_t*)take((size_t)2 * 1024 * 2048 * 2);
    p.w_kv_t = (bf16_t*)take((size_t)512 * 1024 * 2);
    p.w_aq_t = (bf16_t*)take((size_t)2 * 1024 * 1024 * 2);
    p.w_ao_t = (bf16_t*)take((size_t)2 * 1024 * 1024 * 2);
    p.w_pq_t = (bf16_t*)take((size_t)4 * 2048 * 1024 * 2);
    p.wq_b = (bf16_t*)take((size_t)4 * 1024 * 2048 * 2);
    p.subk = (bf16_t*)take((size_t)4 * 2 * 16384 * 2);
    p.u8 = (unsigned char*)take((size_t)4 * 16384 * 1024);
    p.v8 = (unsigned char*)take((size_t)4 * 16384 * 1024);
    p.h = (float*)take((size_t)T_ALL * 1024 * 4);
    p.h2 = (float*)take((size_t)T_ALL * 1024 * 4);
    p.xn = (bf16_t*)take((size_t)T_ALL * 1024 * 2);
    p.xn2 = (bf16_t*)take((size_t)T_ALL * 1024 * 2);
    p.bufA = (bf16_t*)take((size_t)T_ALL * 4096 * 2);
    p.bufB = (bf16_t*)take((size_t)T_ALL * 4096 * 2);
    p.zbuf = (bf16_t*)take((size_t)T_ALL * 2048 * 2);
    p.dtraw = (float*)take((size_t)T_ALL * 32 * 4);
    p.dtsp = (float*)take((size_t)T_ALL * 32 * 4);
    p.decay = (float*)take((size_t)T_ALL * 32 * 4);
    p.ybuf = (float*)take((size_t)T_ALL * 2048 * 4);
    p.eid = (int*)take((size_t)T_ALL * 128 * 4);
    p.gate = (float*)take((size_t)T_ALL * 128 * 4);
    p.wq = (unsigned char*)take((size_t)T_ALL * 128);
    p.wscale = (float*)take((size_t)T_ALL * 4);
    p.ssq_h = (float*)take((size_t)T_ALL * 8 * 4);
    p.ssq_h2 = (float*)take((size_t)T_ALL * 16 * 4);
    p.ssq_y = (float*)take((size_t)T_ALL * 64 * 4);
    p.partial = (float*)p.bufB;
    p.kv = (float*)(p.bufB + (size_t)T_ALL * 2048);
    if (off > ws_size) { fprintf(stderr, "kernel_launch: workspace too small: need %zu have %zu\n", off, ws_size); return; }
    static int grid = 0;
    if (grid == 0) {
        int dev = 0, cus = 0, per_cu = 0;
        (void)hipGetDevice(&dev);
        (void)hipDeviceGetAttribute(&cus, hipDeviceAttributeMultiprocessorCount, dev);
        (void)hipFuncSetAttribute((const void*)mega, hipFuncAttributeMaxDynamicSharedMemorySize, DYN_LDS_BYTES);
        (void)hipOccupancyMaxActiveBlocksPerMultiprocessor(&per_cu, (const void*)mega, NTHREADS, DYN_LDS_BYTES);
        if (per_cu > 2) per_cu = 2;
        if (per_cu < 1) per_cu = 1;
        grid = cus * per_cu;
    }
    (void)hipMemsetAsync(p.bar, 0, XCD_BAR_WORDS * 4, stream);
    p.ph_lo = 0; p.ph_hi = N_PHASES;
    void* args[] = {&p};
    hipError_t e = hipLaunchCooperativeKernel((const void*)mega, dim3(grid), dim3(NTHREADS), args, DYN_LDS_BYTES, stream);
    if (e != hipSuccess) fprintf(stderr, "cooperative launch failed: %s (grid %d)\n", hipGetErrorString(e), grid);
}
```

```cpp
#include <hip/hip_runtime.h>
#include <hip/hip_cooperative_groups.h>
#include <stdint.h>
#include <cstdio>

typedef unsigned short bf16_t;
typedef short bf16x8 __attribute__((ext_vector_type(8)));
typedef float f32x4 __attribute__((ext_vector_type(4)));
typedef unsigned u32x4 __attribute__((ext_vector_type(4)));
typedef unsigned u32x2 __attribute__((ext_vector_type(2)));
typedef float f32x2 __attribute__((ext_vector_type(2)));

#define T_P 16384
#define T_S 512
#define T_ALL 16896
#define DM 1024
#define NTHREADS 256
#define LAS __attribute__((address_space(3)))
#define SMEM_BYTES 65536
#define DYN_LDS_BYTES 81920

#define OFF_Y 0
#define OFF_PR_SSM 17301504
#define OFF_PR_CONV 21495808
#define OFF_PR_K 21692416
#define OFF_PR_V 21954560
#define OFF_SM_SSM 22216704
#define OFF_SM_CONV 38993920
#define OFF_SM_K 39780352
#define OFF_SM_V 40828928

struct Params {
    const float *x_prompt, *x_sample, *state_ssm, *state_conv, *cache_k, *cache_v;
    const float *norm_mix, *norm_ffn, *norm_kv, *norm_final;
    const float *m_w_in, *m_conv_w, *m_conv_b, *m_dt_bias, *m_a_log, *m_d_skip, *m_norm, *m_w_out;
    const float *a_w_kv, *a_b_kv, *a_w_q, *a_b_q, *a_sinks, *a_w_o, *a_b_o;
    const float *p_w_q, *p_sub_k1, *p_sub_k2, *p_u, *p_v;
    float* out;
    bf16_t *w_in_t, *w_out_t, *w_kv_t, *w_aq_t, *w_ao_t, *w_pq_t, *subk, *wq_b;
    unsigned char *u8, *v8;
    float* partial;
    unsigned char* wq;
    float* wscale;
    float *h, *h2;
    bf16_t *xn, *xn2, *bufA, *bufB, *zbuf;
    float *ssq_h, *ssq_h2, *ssq_y;
    float *dtsp, *decay, *dtraw, *ybuf, *kv;
    int* eid;
    float* gate;
    unsigned* bar;
    int ph_lo, ph_hi;
    int wv;
};

__device__ __forceinline__ float bf2f(bf16_t v) { return __uint_as_float(((unsigned)v) << 16); }
__device__ __forceinline__ bf16_t f2bf(float f) { unsigned r; asm("v_cvt_pk_bf16_f32 %0, %1, %1\n\ts_nop 1" : "=v"(r) : "v"(f)); return (bf16_t)(r & 0xffffu); }
__device__ __forceinline__ float bf_lo(unsigned u) { return __uint_as_float(u << 16); }
__device__ __forceinline__ float bf_hi(unsigned u) { return __uint_as_float(u & 0xffff0000u); }
__device__ __forceinline__ unsigned pk2(float lo, float hi) {
    unsigned r; asm("v_cvt_pk_bf16_f32 %0, %1, %2\n\ts_nop 1" : "=v"(r) : "v"(lo), "v"(hi)); return r;
}
__device__ __forceinline__ unsigned pk2_sw(float lo, float hi) {
    unsigned a = __float_as_uint(lo), b = __float_as_uint(hi);
    a += 0x7fffu + ((a >> 16) & 1u);
    b += 0x7fffu + ((b >> 16) & 1u);
    return (a >> 16) | (b & 0xffff0000u);
}
template <int CTRL> __device__ __forceinline__ float dpp_mov(float v) { return __int_as_float(__builtin_amdgcn_update_dpp(0, __float_as_int(v), CTRL, 0xf, 0xf, true)); }
template <int CTRL> __device__ __forceinline__ int dpp_movi(int v) { return __builtin_amdgcn_update_dpp(0, v, CTRL, 0xf, 0xf, true); }
__device__ __forceinline__ float row_sum16(float v) {
    v += dpp_mov<0xB1>(v); v += dpp_mov<0x4E>(v); v += dpp_mov<0x141>(v); v += dpp_mov<0x140>(v); return v;
}
__device__ __forceinline__ float xor16_sum(float v) { const auto r = __builtin_amdgcn_permlane16_swap(__float_as_uint(v), __float_as_uint(v), false, false); return __uint_as_float(r[0]) + __uint_as_float(r[1]); }
__device__ __forceinline__ float xor32_sum(float v) { const auto r = __builtin_amdgcn_permlane32_swap(__float_as_uint(v), __float_as_uint(v), false, false); return __uint_as_float(r[0]) + __uint_as_float(r[1]); }
__device__ __forceinline__ float xor16_max(float v) { const auto r = __builtin_amdgcn_permlane16_swap(__float_as_uint(v), __float_as_uint(v), false, false); return fmaxf(__uint_as_float(r[0]), __uint_as_float(r[1])); }
__device__ __forceinline__ float xor32_max(float v) { const auto r = __builtin_amdgcn_permlane32_swap(__float_as_uint(v), __float_as_uint(v), false, false); return fmaxf(__uint_as_float(r[0]), __uint_as_float(r[1])); }
__device__ __forceinline__ float wave_sum(float v) { return xor32_sum(xor16_sum(row_sum16(v))); }
__device__ __forceinline__ unsigned pack_fp8x4(float a, float b, float c, float d) {
    int w = 0; w = __builtin_amdgcn_cvt_pk_fp8_f32(a, b, w, false); w = __builtin_amdgcn_cvt_pk_fp8_f32(c, d, w, true); return (unsigned)w;
}
__device__ __forceinline__ unsigned pack_i8x4(float a, float b, float c, float d) {
    const int ia = max(-127, min(127, __float2int_rn(a))), ib = max(-127, min(127, __float2int_rn(b))), ic = max(-127, min(127, __float2int_rn(c))), id = max(-127, min(127, __float2int_rn(d)));
    return (unsigned)(ia & 255) | ((unsigned)(ib & 255) << 8) | ((unsigned)(ic & 255) << 16) | ((unsigned)(id & 255) << 24);
}
__device__ __forceinline__ int lt(int wv) { int t; asm volatile("v_mbcnt_lo_u32_b32 %0, -1, 0\n\tv_mbcnt_hi_u32_b32 %0, -1, %0\n\tv_lshl_or_b32 %0, %1, 6, %0" : "=&v"(t) : "s"(wv)); return t; }
__device__ __forceinline__ int lb() { int b = blockIdx.x; asm volatile("" : "+s"(b)); return b; }
#define TIDX lt(p.wv)
#define BIDX lb()
__device__ __forceinline__ float silu_f(float x) { return x * __builtin_amdgcn_rcpf(1.f + __expf(-x)); }
__device__ __forceinline__ float gelu_tanh(float x) {
    const float u = 0.7978845608028654f * (x + 0.044715f * x * x * x);
    const float t = 1.f - 2.f * __builtin_amdgcn_rcpf(__expf(2.f * u) + 1.f);
    return 0.5f * x * (1.f + t);
}

__device__ __forceinline__ void convert_tables(const Params& p, int l0, int nl, size_t vtid, size_t vstride) {
    const size_t np = (size_t)nl * 16384 * 64, base = (size_t)l0 * 16384 * 64;
    const int jfix = (int)(vtid & 63);
    f32x4 gu[2][4];
#pragma unroll
    for (int li = 0; li < 2; ++li)
#pragma unroll
        for (int k = 0; k < 4; ++k) gu[li][k] = *(const f32x4*)(p.norm_ffn + (size_t)(l0 + min(li, nl - 1)) * 1024 + 16 * jfix + 4 * k) * 512.f;
    for (size_t i0 = vtid; i0 < 2 * np; i0 += 4 * vstride) {
        f32x4 a[4][4]; bool ok[4];
#pragma unroll
        for (int u = 0; u < 4; ++u) {
            const size_t i = i0 + (size_t)u * vstride; ok[u] = i < 2 * np;
            if (ok[u]) {
                const bool isv = i >= np; const size_t q = base + (isv ? i - np : i);
                const float* s = (isv ? p.p_v : p.p_u) + (q >> 6) * 1024 + 16 * (q & 63);
#pragma unroll
                for (int k = 0; k < 4; ++k) a[u][k] = __builtin_nontemporal_load((const f32x4*)(s + 4 * k));
            }
        }
#pragma unroll
        for (int u = 0; u < 4; ++u) {
            const size_t i = i0 + (size_t)u * vstride;
            if (ok[u]) {
                const bool isv = i >= np; const size_t q = base + (isv ? i - np : i);
                const int j = (int)(q & 63), e = (int)((q >> 6) & 16383), l = (int)(q >> 20);
                f32x4 g[4];
#pragma unroll
                for (int k = 0; k < 4; ++k) g[k] = isv ? (f32x4){256.f, 256.f, 256.f, 256.f} : (l > l0 ? gu[1][k] : gu[0][k]);
                u32x4 o;
                { const f32x4 v = a[u][0] * g[0]; o.x = pack_i8x4(v.x, v.y, v.z, v.w); }
                { const f32x4 v = a[u][1] * g[1]; o.y = pack_i8x4(v.x, v.y, v.z, v.w); }
                { const f32x4 v = a[u][2] * g[2]; o.z = pack_i8x4(v.x, v.y, v.z, v.w); }
                { const f32x4 v = a[u][3] * g[3]; o.w = pack_i8x4(v.x, v.y, v.z, v.w); }
                unsigned char* dst = (isv ? p.v8 : p.u8) + (((size_t)l * 8 + (j >> 3)) * 16384 + e) * 128 + 16 * (j & 7);
                *(u32x4*)dst = o;
            }
        }
    }
}

struct TJob { const float* src; bf16_t* dst; int K, N, Npad; const float* gk; };
__device__ __forceinline__ TJob get_tjob(const Params& p, int j) {
    TJob t;
    if (j < 2) { t.src = p.m_w_in + (size_t)j * 1024 * 6176; t.dst = p.w_in_t + (size_t)j * 6272 * 1024; t.K = 1024; t.N = 6176; t.Npad = 6272; t.gk = p.norm_mix + (size_t)j * 1024; }
    else if (j < 4) { t.src = p.m_w_out + (size_t)(j - 2) * 2048 * 1024; t.dst = p.w_out_t + (size_t)(j - 2) * 1024 * 2048; t.K = 2048; t.N = 1024; t.Npad = 1024; t.gk = p.m_norm + (size_t)(j - 2) * 2048; }
    else if (j < 5) { t.src = p.a_w_kv; t.dst = p.w_kv_t; t.K = 1024; t.N = 512; t.Npad = 512; t.gk = p.norm_kv; }
    else if (j < 7) { t.src = p.a_w_q + (size_t)(j - 5) * 1024 * 1024; t.dst = p.w_aq_t + (size_t)(j - 5) * 1024 * 1024; t.K = 1024; t.N = 1024; t.Npad = 1024; t.gk = p.norm_mix + (size_t)(2 + j - 5) * 1024; }
    else if (j < 9) { t.src = p.a_w_o + (size_t)(j - 7) * 1024 * 1024; t.dst = p.w_ao_t + (size_t)(j - 7) * 1024 * 1024; t.K = 1024; t.N = 1024; t.Npad = 1024; t.gk = nullptr; }
    else { t.src = p.p_w_q + (size_t)(j - 9) * 1024 * 2048; t.dst = p.w_pq_t + (size_t)(j - 9) * 2048 * 1024; t.K = 1024; t.N = 2048; t.Npad = 2048; t.gk = p.norm_ffn + (size_t)(j - 9) * 1024; }
    return t;
}
#define N_TJOBS 9

__device__ __forceinline__ void convert_transposes(const Params& p, char* smem, int j0, int j1, int vb, int vG) {
    const int tid = TIDX;
    float* scr = (float*)smem;
    int total = 0;
    for (int j = j0; j < j1; ++j) { TJob t = get_tjob(p, j); total += (t.K / 64) * (t.Npad / 64); }
    for (int tile = vb; tile < total; tile += vG) {
        int r = tile, j = j0; TJob t = get_tjob(p, j0);
        for (;;) { const int n = (t.K / 64) * (t.Npad / 64); if (r < n) break; r -= n; ++j; t = get_tjob(p, j); }
        const int nnt = t.Npad / 64, kt = r / nnt, nt = r % nnt, k0 = kt * 64, n0 = nt * 64;
        __syncthreads();
        const float* gkp = t.gk ? t.gk : p.norm_mix;
        const bool has_g = t.gk != nullptr;
        float xv[16], gv[16];
#pragma unroll
        for (int i = 0; i < 16; ++i) {
            const int e = tid + 256 * i, kk = e >> 6, nn = e & 63;
            xv[i] = t.src[(size_t)(k0 + kk) * t.N + min(n0 + nn, t.N - 1)];
            gv[i] = gkp[k0 + kk];
        }
#pragma unroll
        for (int i = 0; i < 16; ++i) {
            const int e = tid + 256 * i, kk = e >> 6, nn = e & 63;
            const float v = xv[i] * (has_g ? gv[i] : 1.f);
            scr[kk * 65 + nn] = (n0 + nn < t.N) ? v : 0.f;
        }
        __syncthreads();
#pragma unroll
        for (int i = 0; i < 2; ++i) {
            const int e = tid + 256 * i, nn = e >> 3, c = e & 7;
            const float* s = scr + (8 * c) * 65 + nn;
            u32x4 o; o.x = pk2(s[0], s[65]); o.y = pk2(s[130], s[195]); o.z = pk2(s[260], s[325]); o.w = pk2(s[390], s[455]);
            *(u32x4*)(t.dst + (size_t)(n0 + nn) * t.K + k0 + 8 * c) = o;
        }
    }
}
__device__ __forceinline__ void phase_convert(const Params& p, char* smem) { convert_transposes(p, smem, 0, 1, BIDX, gridDim.x); }
__device__ __forceinline__ void convert_plain(const Params& p, size_t gtid, size_t gstride) {
    {
        const size_t n8 = (size_t)4 * 2 * 16384 / 8;
        for (size_t i = gtid; i < n8; i += gstride) {
            const size_t e = i * 8; const int l = (int)(e / 32768), hf = (int)((e / 16384) & 1); const size_t off = e & 16383;
            const float* s = (hf ? p.p_sub_k2 : p.p_sub_k1) + (size_t)l * 16384 + off;
            const f32x4 a = *(const f32x4*)s, b = *(const f32x4*)(s + 4);
            u32x4 o; o.x = pk2(a.x, a.y); o.y = pk2(a.z, a.w); o.z = pk2(b.x, b.y); o.w = pk2(b.z, b.w);
            *(u32x4*)(p.subk + e) = o;
        }
    }
    {
        const size_t n8 = (size_t)4 * 1024 * 2048 / 8;
        for (size_t i = gtid; i < n8; i += 4 * gstride) {
            f32x4 a[4], b[4]; float g[4];
#pragma unroll
            for (int u = 0; u < 4; ++u) {
                const size_t e = min(i + u * gstride, n8 - 1) * 8;
                g[u] = p.norm_ffn[e >> 11]; a[u] = *(const f32x4*)(p.p_w_q + e); b[u] = *(const f32x4*)(p.p_w_q + e + 4);
            }
#pragma unroll
            for (int u = 0; u < 4; ++u) {
                if (i + u * gstride < n8) {
                    const size_t e = (i + u * gstride) * 8;
                    const f32x4 av = a[u] * g[u], bv = b[u] * g[u];
                    u32x4 o; o.x = pk2(av.x, av.y); o.y = pk2(av.z, av.w); o.z = pk2(bv.x, bv.y); o.w = pk2(bv.z, bv.w);
                    *(u32x4*)(p.wq_b + e) = o;
                }
            }
        }
    }
}

__device__ __forceinline__ void wave_rmsnorm_store(const f32x4 (&v)[4], const float* g, bf16_t* dst, int lane) {
    float ss = 0.f;
#pragma unroll
    for (int i = 0; i < 4; ++i) ss += v[i].x * v[i].x + v[i].y * v[i].y + v[i].z * v[i].z + v[i].w * v[i].w;
    ss = wave_sum(ss);
    const float inv = rsqrtf(ss * (1.f / 1024.f) + 1e-6f);
#pragma unroll
    for (int i = 0; i < 4; ++i) {
        const f32x4 gv = *(const f32x4*)(g + i * 256 + lane * 4);
        u32x2 o; o.x = pk2(v[i].x * inv * gv.x, v[i].y * inv * gv.y); o.y = pk2(v[i].z * inv * gv.z, v[i].w * inv * gv.w);
        *(u32x2*)(dst + i * 256 + lane * 4) = o;
    }
}

__device__ __forceinline__ void phase_embed(const Params& p) {
    const int lane = TIDX & 63, gw = BIDX * 4 + p.wv, nw = gridDim.x * 4;
    for (int row0 = gw; row0 < T_ALL; row0 += 2 * nw) {
        f32x4 v[2][4];
#pragma unroll
        for (int u = 0; u < 2; ++u) {
            const int row = min(row0 + u * nw, T_ALL - 1);
            const float* src = row < T_P ? p.x_prompt + (size_t)row * DM : p.x_sample + (size_t)(row - T_P) * DM;
#pragma unroll
            for (int i = 0; i < 4; ++i) v[u][i] = *(const f32x4*)(src + i * 256 + lane * 4);
        }
#pragma unroll
        for (int u = 0; u < 2; ++u) {
            const int row = row0 + u * nw;
            if (row < T_ALL) {
                float ss = 0.f;
#pragma unroll
                for (int i = 0; i < 4; ++i) {
                    const f32x4 x = v[u][i];
                    *(f32x4*)(p.h + (size_t)row * DM + i * 256 + lane * 4) = x;
                    u32x2 o; o.x = pk2(x.x, x.y); o.y = pk2(x.z, x.w);
                    *(u32x2*)(p.xn + (size_t)row * DM + i * 256 + lane * 4) = o;
                    ss += x.x * x.x + x.y * x.y + x.z * x.z + x.w * x.w;
                }
                ss = wave_sum(ss);
                if (lane < 8) p.ssq_h[(size_t)row * 8 + lane] = lane == 0 ? ss : 0.f;
            }
        }
    }
}

__device__ __forceinline__ int lds_off(int r, int c) { return r * 128 + ((c ^ ((r >> 1) & 7)) << 4); }

struct RowScale { const float* part; int nparts; float inv_dim; };
template <int MFR, class Epi>
__device__ __forceinline__ void gemm_tile(const bf16_t* __restrict__ A, int lda, const bf16_t* __restrict__ Bt, int ldb, int K,
                                          int m0, int n0, char* smem, const Epi& epi, const RowScale& rs, int wv, bool first = true, bool has_next = false, int m0n = 0, int n0n = 0) {
    const int tid = lt(wv), lane = tid & 63, wid = wv, wm = wid >> 1, wn = wid & 1;
    constexpr int AB = MFR > 4 ? MFR * 4096 : 16384, STG = AB + 16384;
    f32x4 acc[4][MFR];
#pragma unroll
    for (int a = 0; a < 4; ++a)
#pragma unroll
        for (int b = 0; b < MFR; ++b) acc[a][b] = (f32x4){0.f, 0.f, 0.f, 0.f};
    const int nk = K / 64;
    const int srow = wid * 8 + (lane >> 3), schunk = (lane & 7) ^ ((srow >> 1) & 7);
    const bf16_t* ga = A + (size_t)(m0 + srow) * lda + schunk * 8;
    const bf16_t* gb = Bt + (size_t)(n0 + srow) * ldb + schunk * 8;
    auto stage2 = [&](const bf16_t* ga, const bf16_t* gb, int kt, char* buf) {
#pragma unroll
        for (int i = 0; i < (MFR > 4 ? MFR : 4); ++i) {
            if (i < MFR) __builtin_amdgcn_global_load_lds((const unsigned*)(ga + (size_t)(32 * i) * lda + kt * 64), (LAS unsigned*)(buf + (4 * i + wid) * 1024), 16, 0, 0);
            if (i < 4) __builtin_amdgcn_global_load_lds((const unsigned*)(gb + (size_t)(32 * i) * ldb + kt * 64), (LAS unsigned*)(buf + AB + (4 * i + wid) * 1024), 16, 0, 0);
        }
    };
    auto stage = [&](int kt, char* buf) { stage2(ga, gb, kt, buf); };
    bf16x8 xf[2][MFR], wf[2][4];
    auto rd = [&](int fb, const char* cur, int kk) {
        const int c = kk * 4 + (lane >> 4);
#pragma unroll
        for (int im = 0; im < MFR; ++im) xf[fb][im] = *(const bf16x8*)(cur + lds_off(wm * (16 * MFR) + im * 16 + (lane & 15), c));
#pragma unroll
        for (int jn = 0; jn < 4; ++jn) wf[fb][jn] = *(const bf16x8*)(cur + AB + lds_off(wn * 64 + jn * 16 + (lane & 15), c));
    };
    auto mm = [&](int fb, int j0, int j1) {
#pragma unroll
        for (int jn = j0; jn < j1; ++jn)
#pragma unroll
            for (int im = 0; im < MFR; ++im) acc[jn][im] = __builtin_amdgcn_mfma_f32_16x16x32_bf16(wf[fb][jn], xf[fb][im], acc[jn][im], 0, 0, 0);
    };
    if (first) {
        __syncthreads();
        stage(0, smem);
        asm volatile("s_waitcnt vmcnt(0)" ::: "memory");
        __syncthreads();
        if (nk > 1) stage(1, smem + STG);
    } else {
        asm volatile("s_waitcnt vmcnt(0)" ::: "memory");
        __syncthreads();
    }
    rd(0, smem, 0);
    for (int kt = 0; kt < nk; ++kt) {
        char* cur = smem + (kt & 1) * STG;
        char* nxt = smem + ((kt + 1) & 1) * STG;
        mm(0, 0, 1);
        __builtin_amdgcn_sched_barrier(0);
        rd(1, cur, 1);
        __builtin_amdgcn_sched_barrier(0);
        mm(0, 1, 4);
        __builtin_amdgcn_sched_barrier(0);
        asm volatile("s_waitcnt vmcnt(0) lgkmcnt(0)" ::: "memory");
        __syncthreads();
        if (kt + 2 < nk) stage(kt + 2, cur);
        else if (has_next) { const int tl = lt(wv), sr = wv * 8 + ((tl & 63) >> 3), sc = (tl & 7) ^ ((sr >> 1) & 7);
                             stage2(A + (size_t)(m0n + sr) * lda + sc * 8, Bt + (size_t)(n0n + sr) * ldb + sc * 8, kt + 2 - nk, cur); }
        if (kt + 1 < nk) rd(0, nxt, 0);
        __builtin_amdgcn_sched_barrier(0);
        mm(1, 0, 4);
        __builtin_amdgcn_sched_barrier(0);
    }
    f32x4 addv[Epi::kHasPre ? 4 : 1][Epi::kHasPre ? MFR : 1];
    if (Epi::kHasPre) {
#pragma unroll
        for (int im = 0; im < MFR; ++im)
#pragma unroll
            for (int jn = 0; jn < 4; ++jn) addv[Epi::kHasPre ? jn : 0][Epi::kHasPre ? im : 0] = epi.pre(m0 + wm * (16 * MFR) + im * 16 + (lane & 15), n0 + wn * 64 + jn * 16 + (lane >> 4) * 4);
        __builtin_amdgcn_sched_barrier(0);
    }
    float rsc[MFR > 4 ? MFR : 4];
#pragma unroll
    for (int i = 0; i < (MFR > 4 ? MFR : 4); ++i) rsc[i] = 1.f;
    if (rs.part) {
        const int per = rs.nparts >> 2;
        f32x2 pvv[MFR][4];
#pragma unroll
        for (int im = 0; im < MFR; ++im) {
            const float* pp = rs.part + (size_t)(m0 + wm * (16 * MFR) + im * 16 + (lane & 15)) * rs.nparts + (lane >> 4) * per;
#pragma unroll
            for (int q = 0; q < 4; ++q) pvv[im][q] = *(const f32x2*)(pp + min(2 * q, per - 2));
        }
        __builtin_amdgcn_sched_barrier(0);
#pragma unroll
        for (int im = 0; im < MFR; ++im) {
            float sm = 0.f;
#pragma unroll
            for (int q = 0; q < 4; ++q) sm += (2 * q < per) ? pvv[im][q].x + pvv[im][q].y : 0.f;
            sm = xor32_sum(xor16_sum(sm));
            rsc[im] = rsqrtf(sm * rs.inv_dim + 1e-6f);
        }
    }
    if (Epi::kResPack) {
        const int q4 = lane >> 4;
#pragma unroll
        for (int im = 0; im < MFR; ++im) {
            const int m = m0 + wm * (16 * MFR) + im * 16 + (lane & 15);
            f32x4 o[4]; float ss = 0.f;
#pragma unroll
            for (int jn = 0; jn < 4; ++jn) { o[jn] = epi.res4(m, n0 + wn * 64 + jn * 16 + q4 * 4, acc[jn][im] * rsc[im], addv[Epi::kHasPre ? jn : 0][Epi::kHasPre ? im : 0]); ss += (o[jn].x * o[jn].x + o[jn].y * o[jn].y) + (o[jn].z * o[jn].z + o[jn].w * o[jn].w); }
#pragma unroll
            for (int jp = 0; jp < 2; ++jp) {
                const unsigned ax = pk2(o[2 * jp].x, o[2 * jp].y), ay = pk2(o[2 * jp].z, o[2 * jp].w), bx = pk2(o[2 * jp + 1].x, o[2 * jp + 1].y), by = pk2(o[2 * jp + 1].z, o[2 * jp + 1].w);
                const auto s0 = __builtin_amdgcn_permlane16_swap(ax, bx, false, false), s1 = __builtin_amdgcn_permlane16_swap(ay, by, false, false);
                const u32x4 w = {s0[0], s1[0], s0[1], s1[1]};
                epi.store16(m, n0 + wn * 64 + (2 * jp + (q4 & 1)) * 16 + (q4 & 2) * 4, w);
            }
            ss = xor32_sum(xor16_sum(ss)); if (q4 == 0) epi.put_ss(m, (n0 >> 7) * 2 + wn, ss);
        }
        return;
    }
    if (Epi::kPack16 && epi.pack_ok(n0)) {
        const int q4 = lane >> 4;
#pragma unroll
        for (int im = 0; im < MFR; ++im) {
            const int m = m0 + wm * (16 * MFR) + im * 16 + (lane & 15);
#pragma unroll
            for (int jp = 0; jp < 2; ++jp) {
                const u32x2 a = epi.pack4(acc[2 * jp][im] * rsc[im], addv[Epi::kHasPre ? 2 * jp : 0][Epi::kHasPre ? im : 0]), b = epi.pack4(acc[2 * jp + 1][im] * rsc[im], addv[Epi::kHasPre ? 2 * jp + 1 : 0][Epi::kHasPre ? im : 0]);
                const auto s0 = __builtin_amdgcn_permlane16_swap(a.x, b.x, false, false), s1 = __builtin_amdgcn_permlane16_swap(a.y, b.y, false, false);
                const u32x4 w = {s0[0], s1[0], s0[1], s1[1]};
                epi.store16(m, n0 + wn * 64 + (2 * jp + (q4 & 1)) * 16 + (q4 & 2) * 4, w);
            }
        }
        return;
    }
#pragma unroll
    for (int im = 0; im < MFR; ++im) {
        const int m = m0 + wm * (16 * MFR) + im * 16 + (lane & 15);
        float ss = 0.f;
#pragma unroll
        for (int jn = 0; jn < 4; ++jn) ss += epi.store4(m, n0 + wn * 64 + jn * 16 + (lane >> 4) * 4, acc[jn][im] * rsc[im], addv[Epi::kHasPre ? jn : 0][Epi::kHasPre ? im : 0]);
        if (Epi::kWantSS) { ss = xor32_sum(xor16_sum(ss)); if ((lane >> 4) == 0) epi.put_ss(m, (n0 >> 7) * 2 + wn, ss); }
    }
}

template <int MFR, class Epi>
__device__ __forceinline__ void gemm_phase(const bf16_t* A, int lda, const bf16_t* Bt, int ldb, int K, int M, int N, char* smem, const Epi& epi, const RowScale& rs, int wv) {
    const int mt = M / (32 * MFR), nt = N / 128, nwg = mt * nt, G = gridDim.x, bid = BIDX;
    auto tile_of = [&](int L, int& im, int& in) {
        int wgid;
        { const int q = nwg >> 3, r = nwg & 7, xcd = L & 7, off = L >> 3; wgid = (xcd < r ? xcd * (q + 1) : r * (q + 1) + (xcd - r) * q) + off; }
        const int nig = 8 * nt, gid = wgid / nig, fm = gid * 8, gsz = (mt - fm) < 8 ? (mt - fm) : 8;
        im = fm + ((wgid % nig) % gsz); in = (wgid % nig) / gsz;
    };
    for (int L = bid; L < nwg; L += G) {
        int im, in, imn = 0, inn = 0;
        tile_of(L, im, in);
        const bool has_next = L + G < nwg;
        if (has_next) tile_of(L + G, imn, inn);
        gemm_tile<MFR>(A, lda, Bt, ldb, K, im * 32 * MFR, in * 128, smem, epi, rs, wv, L == bid, has_next, imn * 32 * MFR, inn * 128);
    }
    if (MFR > 4) { __syncthreads(); if (lt(wv) == 0) { volatile LAS unsigned* stw = (volatile LAS unsigned*)(smem + DYN_LDS_BYTES - 16); stw[0] = 0u; stw[1] = 0u; } }
}

struct EpiInProj {
    static constexpr bool kWantSS = false, kHasPre = false, kHasBias = false, kPack16 = true, kResPack = false;
    bf16_t* z; bf16_t* xbc; float* dtraw;
    __device__ __forceinline__ f32x4 pre(int, int) const { return (f32x4){0.f, 0.f, 0.f, 0.f}; }
    __device__ __forceinline__ bool pack_ok(int n0) const { return n0 < 6144; }
    __device__ __forceinline__ f32x4 res4(int, int, const f32x4& v, const f32x4&) const { return v; }
    __device__ __forceinline__ u32x2 pack4(const f32x4& v, const f32x4&) const { u32x2 o; o.x = pk2(v.x, v.y); o.y = pk2(v.z, v.w); return o; }
    __device__ __forceinline__ void store16(int m, int n, const u32x4& w) const {
        if (n < 2048) *(u32x4*)(z + (size_t)m * 2048 + n) = w; else *(u32x4*)(xbc + (size_t)m * 4096 + (n - 2048)) = w;
    }
    __device__ __forceinline__ float store4(int m, int n, const f32x4& v, const f32x4&) const {
        if (n < 2048) { u32x2 o; o.x = pk2(v.x, v.y); o.y = pk2(v.z, v.w); *(u32x2*)(z + (size_t)m * 2048 + n) = o; }
        else if (n < 6144) { u32x2 o; o.x = pk2(v.x, v.y); o.y = pk2(v.z, v.w); *(u32x2*)(xbc + (size_t)m * 4096 + (n - 2048)) = o; }
        else if (n < 6176) { *(f32x4*)(dtraw + (size_t)m * 32 + (n - 6144)) = v; }
        return 0.f;
    }
    __device__ __forceinline__ void put_ss(int, int, float) const {}
};
template <bool HB>
struct EpiResidual {
    static constexpr bool kWantSS = true, kHasPre = true, kHasBias = false, kPack16 = false, kResPack = true;
    __device__ __forceinline__ bool pack_ok(int) const { return false; }
    __device__ __forceinline__ u32x2 pack4(const f32x4&, const f32x4&) const { return (u32x2){0u, 0u}; }
    __device__ __forceinline__ f32x4 res4(int m, int n, const f32x4& v, const f32x4& add) const { const f32x4 o = add + v; *(f32x4*)(hout + (size_t)m * DM + n) = o; return o; }
    __device__ __forceinline__ void store16(int m, int n, const u32x4& w) const { *(u32x4*)(hb + (size_t)m * DM + n) = w; }
    const float* hin; float* hout; bf16_t* hb; float* ssq; const float* bias;
    __device__ __forceinline__ f32x4 pre(int m, int n) const {
        const f32x4 r = *(const f32x4*)(hin + (size_t)m * DM + n);
        if (HB) return r + *(const f32x4*)(bias + n);
        return r;
    }
    __device__ __forceinline__ float store4(int m, int n, const f32x4& v, const f32x4& add) const {
        f32x4 o = add + v;
        *(f32x4*)(hout + (size_t)m * DM + n) = o;
        u32x2 w; w.x = pk2(o.x, o.y); w.y = pk2(o.z, o.w);
        *(u32x2*)(hb + (size_t)m * DM + n) = w;
        return (o.x * o.x + o.y * o.y) + (o.z * o.z + o.w * o.w);
    }
    __device__ __forceinline__ void put_ss(int m, int idx, float ss) const { ssq[(size_t)m * 16 + idx] = ss; }
};
template <bool HB>
struct EpiBf16 {
    static constexpr bool kWantSS = false, kHasPre = HB, kHasBias = false, kPack16 = true, kResPack = false;
    bf16_t* out; int ld; const float* bias;
    __device__ __forceinline__ bool pack_ok(int) const { return true; }
    __device__ __forceinline__ f32x4 res4(int, int, const f32x4& v, const f32x4&) const { return v; }
    __device__ __forceinline__ u32x2 pack4(const f32x4& v, const f32x4& add) const { f32x4 q = v; if (HB) q += add; u32x2 o; o.x = pk2(q.x, q.y); o.y = pk2(q.z, q.w); return o; }
    __device__ __forceinline__ void store16(int m, int n, const u32x4& w) const { *(u32x4*)(out + (size_t)m * ld + n) = w; }
    __device__ __forceinline__ f32x4 pre(int, int n) const { if (HB) return *(const f32x4*)(bias + n); return (f32x4){0.f, 0.f, 0.f, 0.f}; }
    __device__ __forceinline__ float store4(int m, int n, const f32x4& v, const f32x4& add) const {
        f32x4 o = v; if (HB) o += add;
        u32x2 w; w.x = pk2(o.x, o.y); w.y = pk2(o.z, o.w);
        *(u32x2*)(out + (size_t)m * ld + n) = w;
        return 0.f;
    }
    __device__ __forceinline__ void put_ss(int, int, float) const {}
};
struct EpiTransBf16 {
    static constexpr bool kWantSS = false, kHasPre = false, kHasBias = false, kPack16 = false, kResPack = false;
    bf16_t* out; int ld;
    __device__ __forceinline__ bool pack_ok(int) const { return false; }
    __device__ __forceinline__ f32x4 res4(int, int, const f32x4& v, const f32x4&) const { return v; }
    __device__ __forceinline__ u32x2 pack4(const f32x4&, const f32x4&) const { return (u32x2){0u, 0u}; }
    __device__ __forceinline__ void store16(int, int, const u32x4&) const {}
    __device__ __forceinline__ f32x4 pre(int, int) const { return (f32x4){0.f, 0.f, 0.f, 0.f}; }
    __device__ __forceinline__ float store4(int m, int n, const f32x4& v, const f32x4&) const {
        const unsigned a = pk2_sw(v.x, v.y), b = pk2_sw(v.z, v.w);
        out[(size_t)n * ld + m] = (bf16_t)(a & 0xffffu); out[(size_t)(n + 1) * ld + m] = (bf16_t)(a >> 16); out[(size_t)(n + 2) * ld + m] = (bf16_t)(b & 0xffffu); out[(size_t)(n + 3) * ld + m] = (bf16_t)(b >> 16);
        return 0.f;
    }
    __device__ __forceinline__ void put_ss(int, int, float) const {}
};
template <bool HB>
struct EpiF32 {
    static constexpr bool kWantSS = false, kHasPre = HB, kHasBias = false, kPack16 = false, kResPack = false;
    float* out; int ld; int coloff; const float* bias;
    __device__ __forceinline__ bool pack_ok(int) const { return false; }
    __device__ __forceinline__ f32x4 res4(int, int, const f32x4& v, const f32x4&) const { return v; }
    __device__ __forceinline__ u32x2 pack4(const f32x4&, const f32x4&) const { return (u32x2){0u, 0u}; }
    __device__ __forceinline__ void store16(int, int, const u32x4&) const {}
    __device__ __forceinline__ f32x4 pre(int, int n) const { if (HB) return *(const f32x4*)(bias + n); return (f32x4){0.f, 0.f, 0.f, 0.f}; }
    __device__ __forceinline__ float store4(int m, int n, const f32x4& v, const f32x4& add) const {
        f32x4 o = v; if (HB) o += add;
        *(f32x4*)(out + (size_t)m * ld + coloff + n) = o;
        return 0.f;
    }
    __device__ __forceinline__ void put_ss(int, int, float) const {}
};

__device__ __forceinline__ void phase_conv(const Params& p, int l) {
    const size_t gtid = (size_t)BIDX * NTHREADS + TIDX, gstride = (size_t)gridDim.x * NTHREADS;
    const float* cw = p.m_conv_w + (size_t)l * 4 * 4096;
    const float* cb = p.m_conv_b + (size_t)l * 4096;
    const bf16_t* xr = p.bufA;
    bf16_t* xc = p.bufB;
    const size_t nitems = (size_t)(T_ALL / 4) * 512;
    const int c0 = (int)(gtid & 511) * 8;
    float wk[4][8], bias[8];
    {
#pragma unroll
        for (int k = 0; k < 4; ++k) {
            const f32x4 w0 = *(const f32x4*)(cw + k * 4096 + c0), w1 = *(const f32x4*)(cw + k * 4096 + c0 + 4);
            wk[k][0] = w0.x; wk[k][1] = w0.y; wk[k][2] = w0.z; wk[k][3] = w0.w; wk[k][4] = w1.x; wk[k][5] = w1.y; wk[k][6] = w1.z; wk[k][7] = w1.w;
        }
        const f32x4 b0 = *(const f32x4*)(cb + c0), b1 = *(const f32x4*)(cb + c0 + 4);
        bias[0] = b0.x; bias[1] = b0.y; bias[2] = b0.z; bias[3] = b0.w; bias[4] = b1.x; bias[5] = b1.y; bias[6] = b1.z; bias[7] = b1.w;
    }
    auto ldrows = [&](size_t it, u32x4 (&raw)[7]) {
        const int t0 = (int)(it >> 9) * 4;
#pragma unroll
        for (int r = 0; r < 7; ++r) raw[r] = *(const u32x4*)(xr + (size_t)max(t0 - 3 + r, 0) * 4096 + c0);
    };
    auto compute = [&](size_t it, const u32x4 (&raw)[7]) {
        const int t0 = (int)(it >> 9) * 4;
        int b, pos0, L; const float* prev = nullptr; float* cso;
        if (t0 < T_P) { b = t0 >> 11; pos0 = t0 & 2047; L = 2048; cso = p.out + OFF_PR_CONV + ((size_t)l * 8 + b) * 3 * 4096; }
        else { const int ts = t0 - T_P; b = ts >> 4; pos0 = ts & 15; L = 16; prev = p.state_conv + ((size_t)l * 32 + b) * 3 * 4096; cso = p.out + OFF_SM_CONV + ((size_t)l * 32 + b) * 3 * 4096; }
        float xv[7][8];
#pragma unroll
        for (int r = 0; r < 7; ++r) {
            const u32x4 u = raw[r];
            xv[r][0] = bf_lo(u.x); xv[r][1] = bf_hi(u.x); xv[r][2] = bf_lo(u.y); xv[r][3] = bf_hi(u.y); xv[r][4] = bf_lo(u.z); xv[r][5] = bf_hi(u.z); xv[r][6] = bf_lo(u.w); xv[r][7] = bf_hi(u.w);
        }
        if (pos0 == 0) {
#pragma unroll
            for (int r = 0; r < 3; ++r) {
                if (prev) {
                    const f32x4 a = *(const f32x4*)(prev + (size_t)r * 4096 + c0), bq = *(const f32x4*)(prev + (size_t)r * 4096 + c0 + 4);
                    xv[r][0] = a.x; xv[r][1] = a.y; xv[r][2] = a.z; xv[r][3] = a.w; xv[r][4] = bq.x; xv[r][5] = bq.y; xv[r][6] = bq.z; xv[r][7] = bq.w;
                } else {
#pragma unroll
                    for (int j = 0; j < 8; ++j) xv[r][j] = 0.f;
                }
            }
        }
#pragma unroll
        for (int o4 = 0; o4 < 4; ++o4) {
            float acc[8];
#pragma unroll
            for (int j = 0; j < 8; ++j) acc[j] = bias[j] + xv[o4][j] * wk[0][j] + xv[o4 + 1][j] * wk[1][j] + xv[o4 + 2][j] * wk[2][j] + xv[o4 + 3][j] * wk[3][j];
            u32x4 o;
            o.x = pk2(silu_f(acc[0]), silu_f(acc[1])); o.y = pk2(silu_f(acc[2]), silu_f(acc[3]));
            o.z = pk2(silu_f(acc[4]), silu_f(acc[5])); o.w = pk2(silu_f(acc[6]), silu_f(acc[7]));
            *(u32x4*)(xc + (size_t)(t0 + o4) * 4096 + c0) = o;
            const int pos = pos0 + o4;
            if (pos >= L - 3) {
                float* d = cso + (size_t)(pos - (L - 3)) * 4096 + c0;
                *(f32x4*)d = (f32x4){xv[o4 + 3][0], xv[o4 + 3][1], xv[o4 + 3][2], xv[o4 + 3][3]};
                *(f32x4*)(d + 4) = (f32x4){xv[o4 + 3][4], xv[o4 + 3][5], xv[o4 + 3][6], xv[o4 + 3][7]};
            }
        }
    };
    if (gtid < nitems) {
        u32x4 rawA[7], rawB[7];
        size_t it = gtid;
        ldrows(it, rawA);
        for (;;) {
            size_t itn = it + gstride;
            ldrows(min(itn, nitems - 1), rawB);
            __builtin_amdgcn_sched_barrier(0);
            compute(it, rawA);
            it = itn; if (it >= nitems) break;
            itn = it + gstride;
            ldrows(min(itn, nitems - 1), rawA);
            __builtin_amdgcn_sched_barrier(0);
            compute(it, rawB);
            it = itn; if (it >= nitems) break;
        }
    }
    for (size_t it = gtid; it < (size_t)T_ALL * 32; it += gstride) {
        const int hh = (int)(it & 31);
        const float x = p.dtraw[it] + p.m_dt_bias[l * 32 + hh];
        const float dt = x > 20.f ? x : __logf(1.f + __expf(x));
        const float A = -__expf(p.m_a_log[l * 32 + hh]);
        p.dtsp[it] = dt;
        p.decay[it] = __expf(dt * A);
    }
}

#define SSD_MS 144u
#define SSD_XS 144u
#define SSD_MT 32768u
#define SSD_XT 41984u
#define SSD_ZT 51200u
#define SSD_AR 60416u
__device__ __forceinline__ unsigned off_b(unsigned row, unsigned ch) { return 256u * row + 16u * (ch ^ (((row & 3u) << 2) | ((row >> 2) & 3u))); }
__device__ __forceinline__ void tr_read8(u32x2 (&d)[8], const unsigned (&a)[8]) {
    asm volatile("ds_read_b64_tr_b16 %0, %8\n\tds_read_b64_tr_b16 %1, %9\n\tds_read_b64_tr_b16 %2, %10\n\tds_read_b64_tr_b16 %3, %11\n\t"
                 "ds_read_b64_tr_b16 %4, %12\n\tds_read_b64_tr_b16 %5, %13\n\tds_read_b64_tr_b16 %6, %14\n\tds_read_b64_tr_b16 %7, %15\n\ts_waitcnt lgkmcnt(0)"
                 : "=&v"(d[0]), "=&v"(d[1]), "=&v"(d[2]), "=&v"(d[3]), "=&v"(d[4]), "=&v"(d[5]), "=&v"(d[6]), "=&v"(d[7])
                 : "v"(a[0]), "v"(a[1]), "v"(a[2]), "v"(a[3]), "v"(a[4]), "v"(a[5]), "v"(a[6]), "v"(a[7]) : "memory");
}
__device__ __forceinline__ void tr_read4(u32x2 (&d)[4], const unsigned (&a)[4]) {
    asm volatile("ds_read_b64_tr_b16 %0, %4\n\tds_read_b64_tr_b16 %1, %5\n\tds_read_b64_tr_b16 %2, %6\n\tds_read_b64_tr_b16 %3, %7\n\ts_waitcnt lgkmcnt(0)"
                 : "=&v"(d[0]), "=&v"(d[1]), "=&v"(d[2]), "=&v"(d[3]) : "v"(a[0]), "v"(a[1]), "v"(a[2]), "v"(a[3]) : "memory");
}
__device__ __forceinline__ bf16x8 frag8(const u32x2& lo, const u32x2& hi) { u32x4 v; v.x = lo.x; v.y = lo.y; v.z = hi.x; v.w = hi.y; return __builtin_bit_cast(bf16x8, v); }

__device__ __forceinline__ void phase_ssd(const Params& p, int l, char* smem) {
    const int tid = TIDX, lane = tid & 63, w = p.wv;
    const int q4 = lane >> 4, c16 = lane & 15;
    const unsigned g = lane >> 4, tq = (lane & 15) >> 2, tp = lane & 3;
    char* Bt = smem; char* Ct = smem + 16384; char* Mt = smem + SSD_MT; char* Xt = smem + SSD_XT; char* Zt = smem + SSD_ZT;
    float* acum = (float*)(smem + SSD_AR); float* dtv = acum + 64; float* wv = acum + 128; float* eA = acum + 192; float* cdec = acum + 256; float* ssql = acum + 260;
    const unsigned lbase = (unsigned)(size_t)smem;
    const bf16_t* xc = p.bufB;
    const int ssd_bid = BIDX, ssd_G = gridDim.x;
    const bool split = ssd_G >= 512;
    const int it_first = split ? (ssd_bid < 256 ? ssd_bid : 256 + (ssd_bid - 256)) : ssd_bid;
    const int it_end = split ? (ssd_bid < 256 ? ssd_bid + 1 : 256 + 1024) : 256 + 1024;
    const int it_step = split ? (ssd_G - 256) : ssd_G;
    for (int item = it_first; item < it_end; item += it_step) {
        int b, hh, nchunks, nvalid, row0; size_t soff; bool has_init;
        if (item < 256) { b = item >> 5; hh = item & 31; nchunks = 32; nvalid = 64; row0 = b * 2048; has_init = false;
                          soff = (size_t)OFF_PR_SSM + (((size_t)l * 8 + b) * 32 + hh) * 8192; }
        else { const int it = item - 256; b = it >> 5; hh = it & 31; nchunks = 1; nvalid = 16; row0 = T_P + b * 16; has_init = true;
               soff = (size_t)OFF_SM_SSM + (((size_t)l * 32 + b) * 32 + hh) * 8192; }
        float* so = p.out + soff;
        const float* si = p.state_ssm + (((size_t)l * 32 + b) * 32 + hh) * 8192;
        const int grp = hh >> 2;
        const float Ah = -__expf(p.m_a_log[l * 32 + hh]), dsk = p.m_d_skip[l * 32 + hh];
        f32x4 sT[8];
#pragma unroll
        for (int nt = 0; nt < 8; ++nt) {
            f32x4 v = (f32x4){0.f, 0.f, 0.f, 0.f};
            if (has_init) v = *(const f32x4*)(si + (size_t)(16 * w + c16) * 128 + 16 * nt + 4 * q4);
            sT[nt] = v;
        }
        __syncthreads();
        u32x4 rB[4], rC[4], rX[2]; float rdt = 0.f;
        auto load_chunk = [&](int c) {
            const int tid = TIDX;
#pragma unroll
            for (int k = 0; k < 4; ++k) {
                const int id = tid + 256 * k, row = id >> 4, ch = id & 15;
                if (row < nvalid) {
                    const bf16_t* src = xc + (size_t)(row0 + c * 64 + row) * 4096 + 2048 + grp * 128 + ch * 8;
                    rB[k] = *(const u32x4*)src; rC[k] = *(const u32x4*)(src + 1024);
                } else { rB[k] = (u32x4){0u, 0u, 0u, 0u}; rC[k] = (u32x4){0u, 0u, 0u, 0u}; }
            }
#pragma unroll
            for (int k = 0; k < 2; ++k) {
                const int id = tid + 256 * k, row = id >> 3, ch = id & 7;
                if (row < nvalid) rX[k] = *(const u32x4*)(xc + (size_t)(row0 + c * 64 + row) * 4096 + hh * 64 + ch * 8);
                else rX[k] = (u32x4){0u, 0u, 0u, 0u};
            }
            if (tid < 64) rdt = (tid < nvalid) ? p.dtsp[(size_t)(row0 + c * 64 + tid) * 32 + hh] : 0.f;
        };
        load_chunk(0);
        for (int c = 0; c < nchunks; ++c) {
#pragma unroll
            for (int k = 0; k < 4; ++k) {
                const unsigned id = tid + 256 * k, row = id >> 4, ch = id & 15;
                *(u32x4*)(Bt + off_b(row, ch)) = rB[k];
                *(u32x4*)(Ct + off_b(row, ch)) = rC[k];
            }
#pragma unroll
            for (int k = 0; k < 2; ++k) {
                const unsigned id = tid + 256 * k, row = id >> 3, ch = id & 7;
                *(u32x4*)(Xt + row * SSD_XS + ch * 16) = rX[k];
            }
            if (w == 0) {
                float v = rdt * Ah;
                v += __int_as_float(__builtin_amdgcn_update_dpp(0, __float_as_int(v), 0x111, 0xf, 0xf, true));
                v += __int_as_float(__builtin_amdgcn_update_dpp(0, __float_as_int(v), 0x112, 0xf, 0xf, true));
                v += __int_as_float(__builtin_amdgcn_update_dpp(0, __float_as_int(v), 0x114, 0xf, 0xf, true));
                v += __int_as_float(__builtin_amdgcn_update_dpp(0, __float_as_int(v), 0x118, 0xf, 0xf, true));
                v += __int_as_float(__builtin_amdgcn_update_dpp(0, __float_as_int(v), 0x142, 0xa, 0xf, false));
                v += __int_as_float(__builtin_amdgcn_update_dpp(0, __float_as_int(v), 0x143, 0xc, 0xf, false));
                const float tot = __int_as_float(__builtin_amdgcn_readlane(__float_as_int(v), 63));
                acum[lane] = v; dtv[lane] = rdt; wv[lane] = rdt * __expf(tot - v); eA[lane] = __expf(v);
                if (lane == 0) cdec[0] = __expf(tot);
            }
            __syncthreads();
            u32x4 rZ[2];
#pragma unroll
            for (int k = 0; k < 2; ++k) {
                const int id = tid + 256 * k, row = id >> 3, ch = id & 7;
                if (row < nvalid) rZ[k] = *(const u32x4*)(p.zbuf + (size_t)(row0 + c * 64 + row) * 2048 + hh * 64 + ch * 8);
                else rZ[k] = (u32x4){0u, 0u, 0u, 0u};
            }
            {
                bf16x8 cf[4];
#pragma unroll
                for (int s4 = 0; s4 < 4; ++s4) cf[s4] = *(const bf16x8*)(Ct + off_b(c16 + 16 * w, 4 * s4 + q4));
                float ai[4];
#pragma unroll
                for (int r = 0; r < 4; ++r) ai[r] = acum[16 * w + 4 * q4 + r];
#pragma unroll
                for (int tj = 0; tj < 4; ++tj) {
                    u32x2 mv; mv.x = 0u; mv.y = 0u;
                    if (tj <= w) {
                        f32x4 cb = (f32x4){0.f, 0.f, 0.f, 0.f};
#pragma unroll
                        for (int s4 = 0; s4 < 4; ++s4) {
                            const bf16x8 bfr = *(const bf16x8*)(Bt + off_b(c16 + 16 * tj, 4 * s4 + q4));
                            cb = __builtin_amdgcn_mfma_f32_16x16x32_bf16(cf[s4], bfr, cb, 0, 0, 0);
                        }
                        const int j = 16 * tj + c16;
                        const float aj = acum[j], dj = dtv[j];
                        float m[4];
#pragma unroll
                        for (int r = 0; r < 4; ++r) { const int i = 16 * w + 4 * q4 + r; m[r] = (j <= i) ? cb[r] * __expf(ai[r] - aj) * dj : 0.f; }
                        mv.x = pk2(m[0], m[1]); mv.y = pk2(m[2], m[3]);
                    }
                    *(u32x2*)(Mt + (16 * tj + c16) * SSD_MS + (16 * w + 4 * q4) * 2) = mv;
                }
            }
            f32x4 yacc[4];
#pragma unroll
            for (int it = 0; it < 4; ++it) yacc[it] = (f32x4){0.f, 0.f, 0.f, 0.f};
#pragma unroll
            for (int kp = 0; kp < 4; ++kp) {
                u32x4 sb;
                sb.x = pk2_sw(sT[2 * kp].x, sT[2 * kp].y); sb.y = pk2_sw(sT[2 * kp].z, sT[2 * kp].w); sb.z = pk2_sw(sT[2 * kp + 1].x, sT[2 * kp + 1].y); sb.w = pk2_sw(sT[2 * kp + 1].z, sT[2 * kp + 1].w);
                const unsigned n0 = 32 * kp + 4 * q4, n1 = n0 + 16;
#pragma unroll
                for (int it = 0; it < 4; ++it) {
                    const unsigned row = 16 * it + c16;
                    const u32x2 lo = *(const u32x2*)(Ct + off_b(row, n0 >> 3) + 8 * ((n0 >> 2) & 1)), hi = *(const u32x2*)(Ct + off_b(row, n1 >> 3) + 8 * ((n1 >> 2) & 1));
                    yacc[it] = __builtin_amdgcn_mfma_f32_16x16x32_bf16(__builtin_bit_cast(bf16x8, sb), frag8(lo, hi), yacc[it], 0, 0, 0);
                }
            }
#pragma unroll
            for (int it = 0; it < 4; ++it) yacc[it] *= eA[16 * it + c16];
#pragma unroll
            for (int k = 0; k < 2; ++k) { const unsigned id = tid + 256 * k, row = id >> 3, ch = id & 7; *(u32x4*)(Zt + row * SSD_XS + ch * 16) = rZ[k]; }
            __syncthreads();
            if (c + 1 < nchunks) load_chunk(c + 1);
            bf16x8 xf[2];
            {
                unsigned ax[4];
#pragma unroll
                for (int ks = 0; ks < 2; ++ks)
#pragma unroll
                    for (int t = 0; t < 2; ++t) ax[ks * 2 + t] = lbase + SSD_XT + (32u * ks + 8u * g + 4u * t + tq) * SSD_XS + (16u * w + 4u * tp) * 2u;
                u32x2 dx[4]; tr_read4(dx, ax);
                xf[0] = frag8(dx[0], dx[1]); xf[1] = frag8(dx[2], dx[3]);
            }
#pragma unroll
            for (int ih = 0; ih < 2; ++ih) {
                unsigned am[8];
#pragma unroll
                for (int ii = 0; ii < 2; ++ii)
#pragma unroll
                    for (int ks = 0; ks < 2; ++ks)
#pragma unroll
                        for (int t = 0; t < 2; ++t) am[(ii * 2 + ks) * 2 + t] = lbase + SSD_MT + (32u * ks + 8u * g + 4u * t + tq) * SSD_MS + (16u * (2 * ih + ii) + 4u * tp) * 2u;
                u32x2 dm[8]; tr_read8(dm, am);
#pragma unroll
                for (int ii = 0; ii < 2; ++ii)
#pragma unroll
                    for (int ks = 0; ks < 2; ++ks)
                        yacc[2 * ih + ii] = __builtin_amdgcn_mfma_f32_16x16x32_bf16(xf[ks], frag8(dm[(ii * 2 + ks) * 2], dm[(ii * 2 + ks) * 2 + 1]), yacc[2 * ih + ii], 0, 0, 0);
            }
#pragma unroll
            for (int it = 0; it < 4; ++it) {
                const int i = 16 * it + c16, pc0 = 16 * w + 4 * q4;
                const u32x2 x4 = *(const u32x2*)(Xt + i * SSD_XS + pc0 * 2), z4 = *(const u32x2*)(Zt + i * SSD_XS + pc0 * 2);
                const float v0 = (yacc[it].x + dsk * bf_lo(x4.x)) * silu_f(bf_lo(z4.x)), v1 = (yacc[it].y + dsk * bf_hi(x4.x)) * silu_f(bf_hi(z4.x));
                const float v2 = (yacc[it].z + dsk * bf_lo(x4.y)) * silu_f(bf_lo(z4.y)), v3 = (yacc[it].w + dsk * bf_hi(x4.y)) * silu_f(bf_hi(z4.y));
                if (i < nvalid) { u32x2 o; o.x = pk2(v0, v1); o.y = pk2(v2, v3); *(u32x2*)(p.bufA + (size_t)(row0 + c * 64 + i) * 2048 + hh * 64 + pc0) = o; }
                const float ssr = xor32_sum(xor16_sum((v0 * v0 + v1 * v1) + (v2 * v2 + v3 * v3)));
                if (q4 == 0) ssql[w * 64 + i] = ssr;
            }
            {
                bf16x8 x2f[2];
#pragma unroll
                for (int ks = 0; ks < 2; ++ks) {
                    const f32x4 w0 = *(const f32x4*)(wv + 32 * ks + 8 * g), w1 = *(const f32x4*)(wv + 32 * ks + 8 * g + 4);
                    const u32x4 u = __builtin_bit_cast(u32x4, xf[ks]);
                    u32x4 o;
                    o.x = pk2(bf_lo(u.x) * w0.x, bf_hi(u.x) * w0.y); o.y = pk2(bf_lo(u.y) * w0.z, bf_hi(u.y) * w0.w);
                    o.z = pk2(bf_lo(u.z) * w1.x, bf_hi(u.z) * w1.y); o.w = pk2(bf_lo(u.w) * w1.z, bf_hi(u.w) * w1.w);
                    x2f[ks] = __builtin_bit_cast(bf16x8, o);
                }
                const float cd = cdec[0];
#pragma unroll
                for (int nq = 0; nq < 4; ++nq) {
                    unsigned ab[8];
#pragma unroll
                    for (int ii = 0; ii < 2; ++ii)
#pragma unroll
                        for (int ks = 0; ks < 2; ++ks)
#pragma unroll
                            for (int t = 0; t < 2; ++t) ab[(ii * 2 + ks) * 2 + t] = lbase + off_b(32u * ks + 8u * g + 4u * t + tq, 2u * (2u * nq + ii) + (tp >> 1)) + 8u * (tp & 1u);
                    u32x2 db[8]; tr_read8(db, ab);
#pragma unroll
                    for (int ii = 0; ii < 2; ++ii) {
                        f32x4 acc = sT[2 * nq + ii] * cd;
#pragma unroll
                        for (int ks = 0; ks < 2; ++ks) acc = __builtin_amdgcn_mfma_f32_16x16x32_bf16(frag8(db[(ii * 2 + ks) * 2], db[(ii * 2 + ks) * 2 + 1]), x2f[ks], acc, 0, 0, 0);
                        sT[2 * nq + ii] = acc;
                    }
                }
            }
            __syncthreads();
            if (tid < 64 && tid < nvalid) p.ssq_y[(size_t)(row0 + c * 64 + tid) * 32 + hh] = (ssql[tid] + ssql[64 + tid]) + (ssql[128 + tid] + ssql[192 + tid]);
        }
#pragma unroll
        for (int nt = 0; nt < 8; ++nt) *(f32x4*)(so + (size_t)(16 * w + c16) * 128 + 16 * nt + 4 * q4) = sT[nt];
    }
    if (split) { if (ssd_bid >= 256) { if (l == 0) { convert_transposes(p, smem, 1, N_TJOBS, ssd_bid - 256, ssd_G - 256); convert_plain(p, (size_t)(ssd_bid - 256) * NTHREADS + tid, (size_t)(ssd_G - 256) * NTHREADS); }
                                       convert_tables(p, 2 * l, 2, (size_t)(ssd_bid - 256) * NTHREADS + tid, (size_t)(ssd_G - 256) * NTHREADS); } }
    else { if (l == 0) { convert_transposes(p, smem, 1, N_TJOBS, ssd_bid, ssd_G); convert_plain(p, (size_t)ssd_bid * NTHREADS + tid, (size_t)ssd_G * NTHREADS); }
           convert_tables(p, 2 * l, 2, (size_t)ssd_bid * NTHREADS + tid, (size_t)ssd_G * NTHREADS); }
}

#define AT_V 24576u
#define AT_VS 144u
__device__ __forceinline__ void phase_attn(const Params& p, int j, char* smem) {
    const int tid = TIDX, lane = tid & 63, w = p.wv, q4 = lane >> 4, c16 = lane & 15;
    const unsigned g = lane >> 4, tq = (lane & 15) >> 2, tp = lane & 3;
    const unsigned lbase = (unsigned)(size_t)smem;
    const bf16_t* qb = p.bufB;
    bf16_t* ob = p.bufB + (size_t)T_ALL * 1024;
    for (int item = BIDX; item < 1024 + 128; item += gridDim.x) {
        const bool prompt = item < 1024;
        int b, c = 0, kvh, qrow0, nqt, klo, khi;
        if (prompt) { b = item >> 7; c = (item >> 2) & 31; kvh = item & 3; qrow0 = b * 2048 + c * 64; nqt = 4; klo = c >= 2 ? 0 : (2 - c) * 64; khi = 192; }
        else { const int s = item - 1024; b = s >> 2; kvh = s & 3; qrow0 = T_P + b * 16; nqt = 1; klo = 0; khi = 144; }
        __syncthreads();
#pragma unroll
        for (int hb = 0; hb < 2; ++hb) {
            f32x4 kq[6], vq[6];
#pragma unroll
            for (int i2 = 0; i2 < 6; ++i2) {
                const int id = tid + 256 * (6 * hb + i2), row = id >> 4, cq = id & 15, rc = min(max(row, klo), khi - 1);
                const float* kp_kv = p.kv + (size_t)(prompt ? b * 2048 + (c - 2) * 64 + rc : T_P + b * 16 + max(rc - 128, 0)) * 512 + kvh * 64;
                const size_t co = ((size_t)(b * 128 + min(rc, 127)) * 4 + kvh) * 64;
                const bool from_cache = !prompt && rc < 128;
                const float* kp = from_cache ? p.cache_k + co : kp_kv;
                const float* vp = from_cache ? p.cache_v + co : kp_kv + 256;
                kq[i2] = *(const f32x4*)(kp + cq * 4); vq[i2] = *(const f32x4*)(vp + cq * 4);
            }
#pragma unroll
            for (int i2 = 0; i2 < 6; ++i2) {
                const int id = tid + 256 * (6 * hb + i2), row = id >> 4, cq = id & 15;
                const bool ok = row >= klo && row < khi;
                const f32x4 z = (f32x4){0.f, 0.f, 0.f, 0.f}, kx = ok ? kq[i2] : z, vx = ok ? vq[i2] : z;
                u32x2 kb, vb; kb.x = pk2(kx.x, kx.y); kb.y = pk2(kx.z, kx.w); vb.x = pk2(vx.x, vx.y); vb.y = pk2(vx.z, vx.w);
                *(u32x2*)(smem + row * 128 + ((((cq >> 1) ^ ((row >> 1) & 7))) << 4) + (cq & 1) * 8) = kb;
                *(u32x2*)(smem + AT_V + row * AT_VS + cq * 8) = vb;
            }
        }
        __syncthreads();
        const int hq = kvh * 4 + w;
        const float sink = p.a_sinks[j * 16 + hq];
        for (int qt = 0; qt < nqt; ++qt) {
            const bf16_t* qp = qb + (size_t)(qrow0 + 16 * qt + c16) * 1024 + hq * 64 + 8 * q4;
            const bf16x8 qf0 = *(const bf16x8*)qp, qf1 = *(const bf16x8*)(qp + 32);
            f32x4 sacc[12];
#pragma unroll
            for (int kt = 0; kt < 12; ++kt) {
                const int r = 16 * kt + c16;
                const bf16x8 kf0 = *(const bf16x8*)(smem + r * 128 + ((q4 ^ ((r >> 1) & 7)) << 4));
                const bf16x8 kf1 = *(const bf16x8*)(smem + r * 128 + (((4 + q4) ^ ((r >> 1) & 7)) << 4));
                f32x4 acc = (f32x4){0.f, 0.f, 0.f, 0.f};
                acc = __builtin_amdgcn_mfma_f32_16x16x32_bf16(kf0, qf0, acc, 0, 0, 0);
                acc = __builtin_amdgcn_mfma_f32_16x16x32_bf16(kf1, qf1, acc, 0, 0, 0);
                sacc[kt] = acc;
            }
            float mx = sink;
#pragma unroll
            for (int kt = 0; kt < 12; ++kt)
#pragma unroll
                for (int r = 0; r < 4; ++r) {
                    const int key = 16 * kt + 4 * q4 + r;
                    const float v = (key >= klo && key < khi) ? sacc[kt][r] * 0.125f : -INFINITY;
                    sacc[kt][r] = v; mx = fmaxf(mx, v);
                }
            mx = xor32_max(xor16_max(mx));
            float lsum = 0.f;
#pragma unroll
            for (int kt = 0; kt < 12; ++kt)
#pragma unroll
                for (int r = 0; r < 4; ++r) { const float pe = __expf(sacc[kt][r] - mx); sacc[kt][r] = pe; lsum += pe; }
            lsum = xor32_sum(xor16_sum(lsum));
            lsum += __expf(sink - mx);
            const float inv = 1.f / lsum;
            bf16x8 pf[6];
#pragma unroll
            for (int kp = 0; kp < 6; ++kp) {
                u32x4 u; u.x = pk2(sacc[2 * kp][0], sacc[2 * kp][1]); u.y = pk2(sacc[2 * kp][2], sacc[2 * kp][3]);
                u.z = pk2(sacc[2 * kp + 1][0], sacc[2 * kp + 1][1]); u.w = pk2(sacc[2 * kp + 1][2], sacc[2 * kp + 1][3]);
                pf[kp] = __builtin_bit_cast(bf16x8, u);
            }
#pragma unroll
            for (int dt = 0; dt < 4; ++dt) {
                unsigned a8[8], a4[4];
#pragma unroll
                for (int kp = 0; kp < 4; ++kp) {
                    a8[2 * kp] = lbase + AT_V + (32u * kp + 4u * g + tq) * AT_VS + (16u * dt + 4u * tp) * 2u;
                    a8[2 * kp + 1] = lbase + AT_V + (32u * kp + 16u + 4u * g + tq) * AT_VS + (16u * dt + 4u * tp) * 2u;
                }
#pragma unroll
                for (int kp = 4; kp < 6; ++kp) {
                    a4[2 * (kp - 4)] = lbase + AT_V + (32u * kp + 4u * g + tq) * AT_VS + (16u * dt + 4u * tp) * 2u;
                    a4[2 * (kp - 4) + 1] = lbase + AT_V + (32u * kp + 16u + 4u * g + tq) * AT_VS + (16u * dt + 4u * tp) * 2u;
                }
                u32x2 d8[8], d4[4]; tr_read8(d8, a8); tr_read4(d4, a4);
                f32x4 oacc = (f32x4){0.f, 0.f, 0.f, 0.f};
#pragma unroll
                for (int kp = 0; kp < 4; ++kp) oacc = __builtin_amdgcn_mfma_f32_16x16x32_bf16(frag8(d8[2 * kp], d8[2 * kp + 1]), pf[kp], oacc, 0, 0, 0);
#pragma unroll
                for (int kp = 4; kp < 6; ++kp) oacc = __builtin_amdgcn_mfma_f32_16x16x32_bf16(frag8(d4[2 * (kp - 4)], d4[2 * (kp - 4) + 1]), pf[kp], oacc, 0, 0, 0);
                u32x2 o; o.x = pk2(oacc.x * inv, oacc.y * inv); o.y = pk2(oacc.z * inv, oacc.w * inv);
                *(u32x2*)(ob + (size_t)(qrow0 + 16 * qt + c16) * 1024 + hq * 64 + 16 * dt + 4 * q4) = o;
            }
        }
    }
}

__device__ __forceinline__ void phase_kvwin(const Params& p) {
    const size_t gtid = (size_t)BIDX * NTHREADS + TIDX, gstride = (size_t)gridDim.x * NTHREADS;
    for (size_t i4 = gtid; i4 < (size_t)8 * 128 * 64; i4 += gstride) {
        const size_t i = i4 * 4; const int b = (int)(i >> 15), r = (int)(i >> 8) & 127, c = (int)(i & 255);
        const float* src = p.kv + (size_t)(b * 2048 + 1920 + r) * 512 + c;
        const f32x4 kk = *(const f32x4*)src, vv = *(const f32x4*)(src + 256);
        *(f32x4*)(p.out + OFF_PR_K + i) = kk; *(f32x4*)(p.out + OFF_PR_V + i) = vv;
    }
    for (size_t i4 = gtid; i4 < (size_t)32 * 128 * 64; i4 += gstride) {
        const size_t i = i4 * 4; const int b = (int)(i >> 15), r = (int)(i >> 8) & 127, c = (int)(i & 255);
        const bool fc = r < 112;
        const size_t co = ((size_t)b * 128 + min(r + 16, 127)) * 256 + c;
        const float* srck = p.kv + (size_t)(T_P + b * 16 + max(r - 112, 0)) * 512 + c;
        const float* kp = fc ? p.cache_k + co : srck;
        const float* vp = fc ? p.cache_v + co : srck + 256;
        const f32x4 kk = *(const f32x4*)kp, vv = *(const f32x4*)vp;
        *(f32x4*)(p.out + OFF_SM_K + i) = kk; *(f32x4*)(p.out + OFF_SM_V + i) = vv;
    }
}

#define TK_CE(a, i, j) { const float hi_ = fmaxf(a[i], a[j]), lo_ = fminf(a[i], a[j]); a[i] = hi_; a[j] = lo_; }
__device__ __forceinline__ void sort16_desc(float (&a)[16]) { TK_CE(a,0,1) TK_CE(a,2,3) TK_CE(a,0,2) TK_CE(a,1,3) TK_CE(a,1,2) TK_CE(a,4,5) TK_CE(a,6,7) TK_CE(a,4,6) TK_CE(a,5,7) TK_CE(a,5,6) TK_CE(a,0,4) TK_CE(a,2,6) TK_CE(a,2,4) TK_CE(a,1,5) TK_CE(a,3,7) TK_CE(a,3,5) TK_CE(a,1,2) TK_CE(a,3,4) TK_CE(a,5,6) TK_CE(a,8,9) TK_CE(a,10,11) TK_CE(a,8,10) TK_CE(a,9,11) TK_CE(a,9,10) TK_CE(a,12,13) TK_CE(a,14,15) TK_CE(a,12,14) TK_CE(a,13,15) TK_CE(a,13,14) TK_CE(a,8,12) TK_CE(a,10,14) TK_CE(a,10,12) TK_CE(a,9,13) TK_CE(a,11,15) TK_CE(a,11,13) TK_CE(a,9,10) TK_CE(a,11,12) TK_CE(a,13,14) TK_CE(a,0,8) TK_CE(a,4,12) TK_CE(a,4,8) TK_CE(a,2,10) TK_CE(a,6,14) TK_CE(a,6,10) TK_CE(a,2,4) TK_CE(a,6,8) TK_CE(a,10,12) TK_CE(a,1,9) TK_CE(a,5,13) TK_CE(a,5,9) TK_CE(a,3,11) TK_CE(a,7,15) TK_CE(a,7,11) TK_CE(a,3,5) TK_CE(a,7,9) TK_CE(a,11,13) TK_CE(a,1,2) TK_CE(a,3,4) TK_CE(a,5,6) TK_CE(a,7,8) TK_CE(a,9,10) TK_CE(a,11,12) TK_CE(a,13,14) }
__device__ __forceinline__ void bitonic16_desc(float (&a)[16]) { TK_CE(a,0,8) TK_CE(a,1,9) TK_CE(a,2,10) TK_CE(a,3,11) TK_CE(a,4,12) TK_CE(a,5,13) TK_CE(a,6,14) TK_CE(a,7,15) TK_CE(a,0,4) TK_CE(a,1,5) TK_CE(a,2,6) TK_CE(a,3,7) TK_CE(a,8,12) TK_CE(a,9,13) TK_CE(a,10,14) TK_CE(a,11,15) TK_CE(a,0,2) TK_CE(a,1,3) TK_CE(a,4,6) TK_CE(a,5,7) TK_CE(a,8,10) TK_CE(a,9,11) TK_CE(a,12,14) TK_CE(a,13,15) TK_CE(a,0,1) TK_CE(a,2,3) TK_CE(a,4,5) TK_CE(a,6,7) TK_CE(a,8,9) TK_CE(a,10,11) TK_CE(a,12,13) TK_CE(a,14,15) }
__device__ __forceinline__ void merge_top16(float (&a)[16], const float (&b)[16]) {
#pragma unroll
    for (int i = 0; i < 16; ++i) a[i] = fmaxf(a[i], b[15 - i]);
    bitonic16_desc(a);
}
__device__ __forceinline__ void ins16(float (&top)[16], float x) {
#pragma unroll
    for (int k = 0; k < 16; ++k) { const float hi = fmaxf(top[k], x); x = fminf(top[k], x); top[k] = hi; }
}
__device__ __forceinline__ void tk_load16(float (&k)[16], const bf16_t* s, int g) {
    const u32x4 a = *(const u32x4*)(s + 16 * g), b = *(const u32x4*)(s + 16 * g + 8);
    const unsigned u[8] = {a.x, a.y, a.z, a.w, b.x, b.y, b.z, b.w};
#pragma unroll
    for (int i = 0; i < 8; ++i) {
        k[2 * i] = __uint_as_float((u[i] << 16) | (unsigned)(16 * g + 2 * i));
        k[2 * i + 1] = __uint_as_float((u[i] & 0xffff0000u) | (unsigned)(16 * g + 2 * i + 1));
    }
}
__device__ __forceinline__ void tk_unpack16(float (&k)[16], const u32x4& a, const u32x4& b, int g) {
    const unsigned u[8] = {a.x, a.y, a.z, a.w, b.x, b.y, b.z, b.w};
#pragma unroll
    for (int i = 0; i < 8; ++i) {
        k[2 * i] = __uint_as_float((u[i] << 16) | (unsigned)(16 * g + 2 * i));
        k[2 * i + 1] = __uint_as_float((u[i] & 0xffff0000u) | (unsigned)(16 * g + 2 * i + 1));
    }
}
__device__ __forceinline__ void tk_top16_of_128(float (&acc)[16], const bf16_t* s) {
    u32x4 raw[16];
#pragma unroll
    for (int i = 0; i < 16; ++i) raw[i] = *(const u32x4*)(s + 8 * i);
    __builtin_amdgcn_sched_barrier(0);
    tk_unpack16(acc, raw[0], raw[1], 0); sort16_desc(acc);
#pragma unroll
    for (int g = 1; g < 8; ++g) { float grp[16]; tk_unpack16(grp, raw[2 * g], raw[2 * g + 1], g); sort16_desc(grp); merge_top16(acc, grp); }
}
__device__ __forceinline__ float tk_cand(const float (&t1)[16], const float (&t2)[16], int i, int j) {
    const float v = __uint_as_float(__float_as_uint(t1[i]) & ~127u) + __uint_as_float(__float_as_uint(t2[j]) & ~127u);
    return __uint_as_float((__float_as_uint(v) & ~255u) | (unsigned)(i * 16 + j));
}
__device__ __forceinline__ void phase_topk(const Params& p, char* smem) {
    const int tid = TIDX;
    const size_t gtid = (size_t)BIDX * NTHREADS + tid, gstride = (size_t)gridDim.x * NTHREADS;
    const bf16_t* sc = (const bf16_t*)p.ybuf;
    unsigned char* myl = (unsigned char*)smem + tid * 36;
    for (size_t row = gtid; row < (size_t)T_ALL * 8; row += gstride) {
        const bf16_t* s = sc + row * 256;
        float t1[16], t2[16];
        tk_top16_of_128(t1, s);
        tk_top16_of_128(t2, s + 128);
#pragma unroll
        for (int q = 0; q < 4; ++q) {
            *(unsigned*)(myl + 4 * q) = (__float_as_uint(t1[4 * q]) & 127u) | ((__float_as_uint(t1[4 * q + 1]) & 127u) << 8) | ((__float_as_uint(t1[4 * q + 2]) & 127u) << 16) | ((__float_as_uint(t1[4 * q + 3]) & 127u) << 24);
            *(unsigned*)(myl + 16 + 4 * q) = (__float_as_uint(t2[4 * q]) & 127u) | ((__float_as_uint(t2[4 * q + 1]) & 127u) << 8) | ((__float_as_uint(t2[4 * q + 2]) & 127u) << 16) | ((__float_as_uint(t2[4 * q + 3]) & 127u) << 24);
        }
        float acc[16], grp[16];
#pragma unroll
        for (int j = 0; j < 16; ++j) acc[j] = tk_cand(t1, t2, 0, j);
        sort16_desc(acc);
        {
            int n = 0;
#pragma unroll
            for (int j = 0; j < 8; ++j) grp[n++] = tk_cand(t1, t2, 1, j);
#pragma unroll
            for (int j = 0; j < 5; ++j) grp[n++] = tk_cand(t1, t2, 2, j);
#pragma unroll
            for (int j = 0; j < 3; ++j) grp[n++] = tk_cand(t1, t2, 3, j);
            sort16_desc(grp); merge_top16(acc, grp);
        }
        {
            int n = 0;
            grp[n++] = tk_cand(t1, t2, 3, 3);
#pragma unroll
            for (int j = 0; j < 3; ++j) grp[n++] = tk_cand(t1, t2, 4, j);
#pragma unroll
            for (int i = 5; i < 8; ++i) { grp[n++] = tk_cand(t1, t2, i, 0); grp[n++] = tk_cand(t1, t2, i, 1); }
#pragma unroll
            for (int i = 8; i < 14; ++i) grp[n++] = tk_cand(t1, t2, i, 0);
            sort16_desc(grp); merge_top16(acc, grp);
        }
        ins16(acc, tk_cand(t1, t2, 14, 0));
        ins16(acc, tk_cand(t1, t2, 15, 0));
        float ex[16], sum = 0.f; int te[16];
        const float v0 = __uint_as_float(__float_as_uint(acc[0]) & ~255u);
#pragma unroll
        for (int k = 0; k < 16; ++k) {
            const unsigned kb = __float_as_uint(acc[k]);
            ex[k] = __expf(__uint_as_float(kb & ~255u) - v0); sum += ex[k];
            te[k] = (int)myl[(kb >> 4) & 15u] * 128 + (int)myl[16 + (kb & 15u)];
        }
        const float inv = 1.f / sum;
        const size_t tt = row >> 3; const int hh = (int)(row & 7);
        int* eo = p.eid + tt * 128; float* go = p.gate + tt * 128;
        const bool odd = (hh & 1) != 0;
#pragma unroll
        for (int a = 0; a < 8; a += 2) {
            const int se0 = odd ? te[a] : te[a + 1], se1 = odd ? te[a + 8] : te[a + 9];
            const int re0 = dpp_movi<0xB1>(se0), re1 = dpp_movi<0xB1>(se1);
            const float g0 = ex[a] * inv, g8 = ex[a + 8] * inv, g1 = ex[a + 1] * inv, g9 = ex[a + 9] * inv;
            const float sg0 = odd ? g0 : g1, sg1 = odd ? g8 : g9;
            const float rg0 = dpp_mov<0xB1>(sg0), rg1 = dpp_mov<0xB1>(sg1);
            const int pos = odd ? (a + 1) * 16 + 2 * (hh - 1) : a * 16 + 2 * hh;
            const int4 ev = odd ? (int4){re0, re1, te[a + 1], te[a + 9]} : (int4){te[a], te[a + 8], re0, re1};
            const f32x4 gv = odd ? (f32x4){rg0, rg1, g1, g9} : (f32x4){g0, g8, rg0, rg1};
            *(int4*)(eo + pos) = ev; *(f32x4*)(go + pos) = gv;
        }
    }
}

__device__ __forceinline__ void peer_load_e(int4 (&ev)[4], const int* eid, int t, int ex) {
    const char* q = (const char*)(eid + (size_t)t * 128);
#pragma unroll
    for (int i = 0; i < 4; ++i) ev[i] = *(const int4*)(q + (unsigned)(ex * 64 + 16 * i));
}
__device__ __forceinline__ void peer_load_r(u32x4 (&r)[16], const int4 (&ev)[4], const unsigned char* tab, unsigned pc) {
#pragma unroll
    for (int i = 0; i < 4; ++i) {
        r[4 * i + 0] = *(const u32x4*)(tab + (size_t)((unsigned)ev[i].x * 128u + pc)); r[4 * i + 1] = *(const u32x4*)(tab + (size_t)((unsigned)ev[i].y * 128u + pc));
        r[4 * i + 2] = *(const u32x4*)(tab + (size_t)((unsigned)ev[i].z * 128u + pc)); r[4 * i + 3] = *(const u32x4*)(tab + (size_t)((unsigned)ev[i].w * 128u + pc));
    }
}

__device__ __forceinline__ void g1_compute(const Params& p, const u32x4 (&r)[16], unsigned xr, int t, int s, int sub, int lane, char* xs) {
    const float x0 = bf_lo(xr), x1 = bf_hi(xr);
    float am = fmaxf(fabsf(x0), fabsf(x1));
    am = fmaxf(am, dpp_mov<0xB1>(am)); am = fmaxf(am, dpp_mov<0x4E>(am)); am = fmaxf(am, dpp_mov<0x141>(am)); am = fmaxf(am, dpp_mov<0x140>(am));
    am = xor32_max(xor16_max(am));
    am = fmaxf(am, 1e-20f);
    const float qs = 127.f / am;
    const int i0 = max(-127, min(127, __float2int_rn(x0 * qs))), i1 = max(-127, min(127, __float2int_rn(x1 * qs)));
    *(unsigned short*)(xs + 2 * lane) = (unsigned short)((i0 & 255) | ((i1 & 255) << 8));
    const u32x4 qv = *(const u32x4*)(xs + 16 * sub);
    const unsigned qx[4] = {qv.x, qv.y, qv.z, qv.w};
    int d[16];
#pragma unroll
    for (int g = 0; g < 16; ++g) {
        int acc = __builtin_amdgcn_sdot4((int)r[g].x, (int)qx[0], 0, false);
        acc = __builtin_amdgcn_sdot4((int)r[g].y, (int)qx[1], acc, false);
        acc = __builtin_amdgcn_sdot4((int)r[g].z, (int)qx[2], acc, false);
        acc = __builtin_amdgcn_sdot4((int)r[g].w, (int)qx[3], acc, false);
        d[g] = acc;
    }
    const bool b2 = (sub & 4) != 0, b1 = (sub & 2) != 0, b0 = (sub & 1) != 0;
    int n8[8], n4[4], n2[2];
#pragma unroll
    for (int i = 0; i < 8; ++i) { const int send = b2 ? d[i] : d[8 + i], keep = b2 ? d[8 + i] : d[i]; n8[i] = keep + dpp_movi<0x141>(send); }
#pragma unroll
    for (int i = 0; i < 4; ++i) { const int send = b1 ? n8[i] : n8[4 + i], keep = b1 ? n8[4 + i] : n8[i]; n4[i] = keep + dpp_movi<0x4E>(send); }
#pragma unroll
    for (int i = 0; i < 2; ++i) { const int send = b0 ? n4[i] : n4[2 + i], keep = b0 ? n4[2 + i] : n4[i]; n2[i] = keep + dpp_movi<0xB1>(send); }
    const float sc = am * (1.f / (127.f * 512.f));
    char* po = (char*)(p.partial + ((size_t)t * 8 + s) * 128);
    *(float*)(po + (unsigned)(4 * lane)) = (float)n2[0] * sc; *(float*)(po + (unsigned)(4 * lane + 256)) = (float)n2[1] * sc;
}
__device__ __forceinline__ void phase_g1(const Params& p, int l, char* smem) {
    const int tid = TIDX, lane = tid & 63, w = __builtin_amdgcn_readfirstlane(tid >> 6), bid = BIDX;
    const int nrank = gridDim.x >> 3;
    if (bid >= nrank * 8) return;
    const int s = bid & 7, rank = bid >> 3, sub = lane & 7, ex = lane >> 3, stride = nrank * 4;
    const unsigned char* ut = p.u8 + ((size_t)l * 8 + s) * 16384 * 128;
    const unsigned pc = 16u * sub;
    const bf16_t* xb = p.xn2 + 128 * s; const unsigned xo = 4u * lane;
    char* xs = smem + 128 * w;
    int t = rank * 4 + w;
    if (t >= T_ALL) return;
    int4 e0[4], e1[4]; u32x4 rA[16], rB[16]; unsigned xA, xB;
    peer_load_e(e0, p.eid, t, ex); peer_load_e(e1, p.eid, min(t + stride, T_ALL - 1), ex);
    peer_load_r(rA, e0, ut, pc);
    xA = *(const unsigned*)((const char*)(xb + (size_t)t * DM) + xo);
    for (;;) {
        {
            const int tn = t + stride, tc = min(tn, T_ALL - 1), tcc = min(tn + stride, T_ALL - 1);
            peer_load_e(e0, p.eid, tcc, ex);
            peer_load_r(rB, e1, ut, pc); xB = *(const unsigned*)((const char*)(xb + (size_t)tc * DM) + xo);
            __builtin_amdgcn_sched_barrier(0);
            g1_compute(p, rA, xA, t, s, sub, lane, xs);
            t = tn; if (t >= T_ALL) break;
        }
        {
            const int tn = t + stride, tc = min(tn, T_ALL - 1), tcc = min(tn + stride, T_ALL - 1);
            peer_load_e(e1, p.eid, tcc, ex);
            peer_load_r(rA, e0, ut, pc); xA = *(const unsigned*)((const char*)(xb + (size_t)tc * DM) + xo);
            __builtin_amdgcn_sched_barrier(0);
            g1_compute(p, rB, xB, t, s, sub, lane, xs);
            t = tn; if (t >= T_ALL) break;
        }
    }
}

__device__ __forceinline__ void phase_w(const Params& p) {
    const int lane = TIDX & 63, gw = BIDX * 4 + p.wv, nw = gridDim.x * 4;
    for (int t0 = gw; t0 < T_ALL; t0 += 2 * nw) {
        float sm[2][2], gt[2][2], sq[2];
        f32x4 qv[2][4]; float pv[2][2][8];
#pragma unroll
        for (int u = 0; u < 2; ++u) {
            const int t = min(t0 + u * nw, T_ALL - 1);
#pragma unroll
            for (int q = 0; q < 4; ++q) qv[u][q] = *(const f32x4*)(p.ssq_h2 + (size_t)t * 16 + q * 4);
#pragma unroll
            for (int j = 0; j < 2; ++j) {
                const int pos = 2 * lane + j, ex = pos >> 4, g = pos & 15, pslot = (g & 1) * 64 + ex * 8 + (g >> 1);
#pragma unroll
                for (int s2 = 0; s2 < 8; ++s2) pv[u][j][s2] = p.partial[((size_t)t * 8 + s2) * 128 + pslot];
                gt[u][j] = p.gate[(size_t)t * 128 + pos];
            }
        }
        __builtin_amdgcn_sched_barrier(0);
#pragma unroll
        for (int u = 0; u < 2; ++u) {
            float q4s = 0.f;
#pragma unroll
            for (int q = 0; q < 4; ++q) q4s += (qv[u][q].x + qv[u][q].y) + (qv[u][q].z + qv[u][q].w);
            sq[u] = q4s;
#pragma unroll
            for (int j = 0; j < 2; ++j) sm[u][j] = ((pv[u][j][0] + pv[u][j][1]) + (pv[u][j][2] + pv[u][j][3])) + ((pv[u][j][4] + pv[u][j][5]) + (pv[u][j][6] + pv[u][j][7]));
        }
#pragma unroll
        for (int u = 0; u < 2; ++u) {
            const int t = t0 + u * nw;
            if (t < T_ALL) {
                const float rr = rsqrtf(sq[u] * (1.f / 1024.f) + 1e-6f);
                const float w0 = gt[u][0] * gelu_tanh(sm[u][0] * rr), w1 = gt[u][1] * gelu_tanh(sm[u][1] * rr);
                float wm = fmaxf(fabsf(w0), fabsf(w1));
                wm = fmaxf(wm, dpp_mov<0xB1>(wm)); wm = fmaxf(wm, dpp_mov<0x4E>(wm)); wm = fmaxf(wm, dpp_mov<0x141>(wm)); wm = fmaxf(wm, dpp_mov<0x140>(wm));
                wm = xor32_max(xor16_max(wm));
                wm = fmaxf(wm, 1e-30f);
                const float qs = 127.f / wm;
                const int q0 = max(-127, min(127, __float2int_rn(w0 * qs))), q1 = max(-127, min(127, __float2int_rn(w1 * qs)));
                *(unsigned short*)(p.wq + (size_t)t * 128 + 2 * lane) = (unsigned short)((q0 & 255) | ((q1 & 255) << 8));
                if (lane == 0) p.wscale[t] = wm * (1.f / (127.f * 256.f));
            }
        }
    }
}

template <class Pre>
__device__ __forceinline__ void g2_compute(const Params& p, const u32x4 (&r)[16], const u32x4& wq, float wsc, const f32x2& hv, int t, int s, int sub, int lane, Pre&& pre) {
    int acc[16];
#pragma unroll
    for (int i = 0; i < 16; ++i) acc[i] = 0;
#pragma unroll
    for (int gq = 0; gq < 4; ++gq) {
        pre(gq);
        __builtin_amdgcn_sched_barrier(0);
        const int wp = (int)wq[gq];
#pragma unroll
        for (int i = 0; i < 4; ++i) {
            const unsigned a = r[4 * gq][i], b = r[4 * gq + 1][i], c = r[4 * gq + 2][i], d = r[4 * gq + 3][i];
            const unsigned ab_lo = __builtin_amdgcn_perm(b, a, 0x05010400u), ab_hi = __builtin_amdgcn_perm(b, a, 0x07030602u);
            const unsigned cd_lo = __builtin_amdgcn_perm(d, c, 0x05010400u), cd_hi = __builtin_amdgcn_perm(d, c, 0x07030602u);
            const unsigned t0 = __builtin_amdgcn_perm(cd_lo, ab_lo, 0x05040100u), t1 = __builtin_amdgcn_perm(cd_lo, ab_lo, 0x07060302u);
            const unsigned t2 = __builtin_amdgcn_perm(cd_hi, ab_hi, 0x05040100u), t3 = __builtin_amdgcn_perm(cd_hi, ab_hi, 0x07060302u);
            acc[4 * i + 0] = __builtin_amdgcn_sdot4((int)t0, wp, acc[4 * i + 0], false);
            acc[4 * i + 1] = __builtin_amdgcn_sdot4((int)t1, wp, acc[4 * i + 1], false);
            acc[4 * i + 2] = __builtin_amdgcn_sdot4((int)t2, wp, acc[4 * i + 2], false);
            acc[4 * i + 3] = __builtin_amdgcn_sdot4((int)t3, wp, acc[4 * i + 3], false);
        }
    }
    const bool b5 = (lane & 32) != 0, b4 = (lane & 16) != 0, b3 = (lane & 8) != 0;
    int n8[8], n4[4], n2[2];
#pragma unroll
    for (int i = 0; i < 8; ++i) { const auto r2 = __builtin_amdgcn_permlane32_swap((unsigned)acc[i], (unsigned)acc[8 + i], false, false); n8[i] = (int)(r2[0] + r2[1]); }
#pragma unroll
    for (int i = 0; i < 4; ++i) { const auto r2 = __builtin_amdgcn_permlane16_swap((unsigned)n8[i], (unsigned)n8[4 + i], false, false); n4[i] = (int)(r2[0] + r2[1]); }
#pragma unroll
    for (int i = 0; i < 2; ++i) { const int send = b3 ? n4[i] : n4[2 + i], keep = b3 ? n4[2 + i] : n4[i]; n2[i] = keep + dpp_movi<0x128>(send); }
    const int src = ((lane & 7) << 5) | ((lane >> 3) << 2);
    const int m0 = __builtin_amdgcn_ds_bpermute(src, n2[0]), m1 = __builtin_amdgcn_ds_bpermute(src, n2[1]);
    const size_t o = (size_t)t * DM + 128 * s;
    const f32x2 ho = hv + (f32x2){(float)m0 * wsc, (float)m1 * wsc};
    *(f32x2*)((char*)(p.h + o) + (unsigned)(8 * lane)) = ho;
    *(unsigned*)((char*)(p.xn + o) + (unsigned)(4 * lane)) = pk2(ho.x, ho.y);
    const float ss = wave_sum(ho.x * ho.x + ho.y * ho.y);
    if (lane == 0) p.ssq_h[(size_t)t * 8 + s] = ss;
}
__device__ __forceinline__ void phase_g2(const Params& p, int l, int mode) {
    const int tid = TIDX, lane = tid & 63, w = __builtin_amdgcn_readfirstlane(tid >> 6), bid = BIDX;
    const int nrank = gridDim.x >> 3;
    if (bid >= nrank * 8) return;
    const int s = bid & 7, rank = bid >> 3, sub = lane & 7, ex = lane >> 3, stride = nrank * 4;
    const unsigned char* vt = p.v8 + ((size_t)l * 8 + s) * 16384 * 128;
    const unsigned pc = 16u * sub;
    const float* hb = p.h2 + 128 * s; const unsigned ho8 = 8u * lane;
    const unsigned char* wb = p.wq; const unsigned wo = 16u * ex;
    int t = rank * 4 + w;
    if (t >= T_ALL) return;
    int4 e0[4], e1[4]; u32x4 rA[16], rB[16], wA, wB; f32x2 hA, hB; float sA, sB;
    peer_load_e(e0, p.eid, t, ex); peer_load_e(e1, p.eid, min(t + stride, T_ALL - 1), ex);
    if (mode != 1) peer_load_r(rA, e0, vt, pc);
    wA = *(const u32x4*)(wb + (size_t)t * 128 + wo); sA = p.wscale[t]; hA = *(const f32x2*)((const char*)(hb + (size_t)t * DM) + ho8);
    for (;;) {
        {
            const int tn = t + stride, tc = min(tn, T_ALL - 1), tcc = min(tn + stride, T_ALL - 1);
            peer_load_e(e0, p.eid, tcc, ex);
            wB = *(const u32x4*)(wb + (size_t)tc * 128 + wo); sB = p.wscale[tc]; hB = *(const f32x2*)((const char*)(hb + (size_t)tc * DM) + ho8);
            __builtin_amdgcn_sched_barrier(0);
            if (mode != 2) g2_compute(p, rA, wA, sA, hA, t, s, sub, lane, [&](int gq) {
                rB[4 * gq + 0] = *(const u32x4*)(vt + (size_t)((unsigned)e1[gq].x * 128u + pc)); rB[4 * gq + 1] = *(const u32x4*)(vt + (size_t)((unsigned)e1[gq].y * 128u + pc));
                rB[4 * gq + 2] = *(const u32x4*)(vt + (size_t)((unsigned)e1[gq].z * 128u + pc)); rB[4 * gq + 3] = *(const u32x4*)(vt + (size_t)((unsigned)e1[gq].w * 128u + pc)); }); else { unsigned x = 0; _Pragma("unroll") for (int i = 0; i < 16; ++i) x |= rA[i].x | rA[i].y | rA[i].z | rA[i].w; asm volatile("" :: "v"(x), "v"(wA), "v"(sA), "v"(hA)); }
            t = tn; if (t >= T_ALL) break;
        }
        {
            const int tn = t + stride, tc = min(tn, T_ALL - 1), tcc = min(tn + stride, T_ALL - 1);
            peer_load_e(e1, p.eid, tcc, ex);
            wA = *(const u32x4*)(wb + (size_t)tc * 128 + wo); sA = p.wscale[tc]; hA = *(const f32x2*)((const char*)(hb + (size_t)tc * DM) + ho8);
            __builtin_amdgcn_sched_barrier(0);
            if (mode != 2) g2_compute(p, rB, wB, sB, hB, t, s, sub, lane, [&](int gq) {
                rA[4 * gq + 0] = *(const u32x4*)(vt + (size_t)((unsigned)e0[gq].x * 128u + pc)); rA[4 * gq + 1] = *(const u32x4*)(vt + (size_t)((unsigned)e0[gq].y * 128u + pc));
                rA[4 * gq + 2] = *(const u32x4*)(vt + (size_t)((unsigned)e0[gq].z * 128u + pc)); rA[4 * gq + 3] = *(const u32x4*)(vt + (size_t)((unsigned)e0[gq].w * 128u + pc)); }); else { unsigned x = 0; _Pragma("unroll") for (int i = 0; i < 16; ++i) x |= rB[i].x | rB[i].y | rB[i].z | rB[i].w; asm volatile("" :: "v"(x), "v"(wB), "v"(sB), "v"(hB)); }
            t = tn; if (t >= T_ALL) break;
        }
    }
}

__device__ __forceinline__ void phase_final(const Params& p) {
    const int lane = TIDX & 63, gw = BIDX * 4 + p.wv, nw = gridDim.x * 4;
    f32x4 gv[4];
#pragma unroll
    for (int i = 0; i < 4; ++i) gv[i] = *(const f32x4*)(p.norm_final + i * 256 + lane * 4);
    for (int row0 = gw; row0 < T_ALL; row0 += 2 * nw) {
        f32x4 v[2][4];
#pragma unroll
        for (int u = 0; u < 2; ++u)
#pragma unroll
            for (int i = 0; i < 4; ++i) v[u][i] = *(const f32x4*)(p.h + (size_t)min(row0 + u * nw, T_ALL - 1) * DM + i * 256 + lane * 4);
#pragma unroll
        for (int u = 0; u < 2; ++u) {
            const int row = row0 + u * nw;
            float ss = 0.f;
#pragma unroll
            for (int i = 0; i < 4; ++i) ss += v[u][i].x * v[u][i].x + v[u][i].y * v[u][i].y + v[u][i].z * v[u][i].z + v[u][i].w * v[u][i].w;
            ss = wave_sum(ss);
            const float inv = rsqrtf(ss * (1.f / 1024.f) + 1e-6f);
            if (row < T_ALL) {
#pragma unroll
                for (int i = 0; i < 4; ++i) *(f32x4*)(p.out + OFF_Y + (size_t)row * DM + i * 256 + lane * 4) = v[u][i] * inv * gv[i];
            }
        }
    }
}

#define XB_TMO      128
#define XB_XCNT(j)  (256  + 64 * (j))
#define XB_XSUB(j)  (1280 + 64 * (j))
#define XB_XGEN(j)  (2304 + 64 * (j))
#define XB_TOP      3328
#define XB_TOPGEN   3392
#define XCD_BAR_WORDS 3456
#define XB_SPIN_CAP (1u << 20)
__device__ __forceinline__ unsigned xb_ld(unsigned* p)              { return __hip_atomic_load(p, __ATOMIC_RELAXED, __HIP_MEMORY_SCOPE_AGENT); }
__device__ __forceinline__ unsigned xb_add(unsigned* p, unsigned v) { return __hip_atomic_fetch_add(p, v, __ATOMIC_RELAXED, __HIP_MEMORY_SCOPE_AGENT); }
__device__ __forceinline__ unsigned xb_xcc_id() { return (unsigned)__builtin_amdgcn_s_getreg((3 << 11) | 20) & 0xFu; }
#define XB_SPIN(cond, bar) do { unsigned _sp = 0; while (cond) { __builtin_amdgcn_s_sleep(1); \
    if ((++_sp & 255u) == 0u) { if (xb_ld(&(bar)[XB_TMO])) break; if (_sp > XB_SPIN_CAP) { atomicAdd(&(bar)[XB_TMO], 1u); break; } } } } while (0)
struct XcdBarrier { unsigned* bar; unsigned x; volatile LAS unsigned* st; int wv; };
__device__ __forceinline__ XcdBarrier xcd_barrier_post(unsigned* bar, volatile LAS unsigned* st, int wv) {
    XcdBarrier b; b.bar = bar; b.x = xb_xcc_id(); b.st = st; b.wv = wv;
    if (lt(wv) == 0) (void)xb_add(&bar[XB_XCNT(b.x)], 1u);
    return b;
}
__device__ __forceinline__ void xcd_barrier_complete(unsigned* bar, unsigned x, unsigned& nloc, unsigned& nx) {
    const unsigned G = gridDim.x * gridDim.y * gridDim.z;
    unsigned sum, cnt, mine, sp = 0u;
    for (;;) {
        sum = 0u; cnt = 0u; mine = 0u;
#pragma unroll
        for (unsigned j = 0; j < 16; ++j) { const unsigned c = xb_ld(&bar[XB_XCNT(j)]); sum += c; cnt += (c > 0u) ? 1u : 0u; mine = (j == x) ? c : mine; }
        if (sum == G) break;
        __builtin_amdgcn_s_sleep(1);
        if ((++sp & 255u) == 0u) { if (xb_ld(&bar[XB_TMO])) break; if (sp > XB_SPIN_CAP) { atomicAdd(&bar[XB_TMO], 1u); break; } }
    }
    nloc = mine > 0u ? mine : 1u; nx = cnt > 0u ? cnt : 1u;
}
__device__ __forceinline__ void xcd_barrier(const XcdBarrier& b) {
    asm volatile("s_waitcnt vmcnt(0)" ::: "memory");
    __syncthreads();
    if (lt(b.wv) == 0) {
        unsigned* bar = b.bar;
        __builtin_amdgcn_s_waitcnt(0);
        unsigned nloc = b.st[0], nx = b.st[1];
        if (nloc == 0u) { xcd_barrier_complete(bar, b.x, nloc, nx); b.st[0] = nloc; b.st[1] = nx; }
        const unsigned old = xb_add(&bar[XB_XSUB(b.x)], 1u);
        const unsigned gen = old / nloc;
        if (old + 1u == (gen + 1u) * nloc) {
            __builtin_amdgcn_fence(__ATOMIC_RELEASE, "agent");
            asm volatile("s_waitcnt vmcnt(0)" ::: "memory");
            const unsigned og = xb_add(&bar[XB_TOP], 1u);
            const unsigned tg = og / nx;
            if (og + 1u == (tg + 1u) * nx) xb_add(&bar[XB_TOPGEN], 1u);
            else XB_SPIN(xb_ld(&bar[XB_TOPGEN]) == tg, bar);
            __builtin_amdgcn_fence(__ATOMIC_ACQUIRE, "agent");
            xb_add(&bar[XB_XGEN(b.x)], 1u);
            asm volatile("s_waitcnt vmcnt(0)" ::: "memory");
        } else {
            XB_SPIN(xb_ld(&bar[XB_XGEN(b.x)]) == gen, bar);
            __builtin_amdgcn_fence(__ATOMIC_ACQUIRE, "agent");
            asm volatile("s_waitcnt vmcnt(0)" ::: "memory");
        }
    }
    __syncthreads();
}

#define N_PHASES 37

__device__ __forceinline__ void phase_wfuse(const Params& p, char* smem) {
    const RowScale rs{nullptr, 0, 0.f};
    for (int id = BIDX; id < 512; id += gridDim.x) {
        const int l = id >> 7, hh = (id >> 3) & 15, mt = id & 7;
        EpiTransBf16 e{p.w_pq_t + ((size_t)l * 2048 + hh * 128) * 1024, 1024};
        gemm_tile<4>(p.wq_b + (size_t)l * 1024 * 2048 + hh * 128, 2048, p.subk + ((size_t)l * 2 + (hh & 1)) * 16384, 128, 128, mt * 128, 0, smem, e, rs, p.wv);
    }
}

#ifndef PROBE_G2_MODE
#define PROBE_G2_MODE 0
#endif
__device__ __forceinline__ void run_peer_phase(const Params& p, int l, int sub, char* smem, bool probe) {
    if (sub == 0) { EpiBf16<false> e{(bf16_t*)p.ybuf, 2048, nullptr}; RowScale rs{p.ssq_h2, 16, 1.f / 1024.f}; gemm_phase<6>(p.xn2, DM, p.w_pq_t + (size_t)l * 2048 * 1024, DM, 1024, T_ALL, 2048, smem, e, rs, p.wv); }
    else if (sub == 1) phase_topk(p, smem);
    else if (sub == 2) phase_g1(p, l, smem);
    else if (sub == 3) phase_w(p);
    else phase_g2(p, l, probe ? PROBE_G2_MODE : 0);
}

__device__ __forceinline__ void run_phase(const Params& p, int ph, char* smem, bool probe = false) {
    if (ph == 0) { phase_convert(p, smem); phase_embed(p); return; }
    if (ph == 1) return;
    if (ph == N_PHASES - 1) { phase_final(p); return; }
    const RowScale rs_h{p.ssq_h, 8, 1.f / 1024.f}, rs_none{nullptr, 0, 0.f};
    if (ph < 20) {
        const int l = (ph - 2) / 9, sub = (ph - 2) % 9;
        if (sub == 0) { EpiInProj e{p.zbuf, p.bufA, p.dtraw}; gemm_phase<6>(p.xn, DM, p.w_in_t + (size_t)l * 6272 * 1024, DM, 1024, T_ALL, 6272, smem, e, rs_h, p.wv); }
        else if (sub == 1) phase_conv(p, l);
        else if (sub == 2) phase_ssd(p, l, smem);
        else if (sub == 3) { EpiResidual<false> e{p.h, p.h2, p.xn2, p.ssq_h2, nullptr}; RowScale rs{p.ssq_y, 32, 1.f / 2048.f};
                             gemm_phase<3>(p.bufA, 2048, p.w_out_t + (size_t)l * 1024 * 2048, 2048, 2048, T_ALL, 1024, smem, e, rs, p.wv);
                             if (l == 0) phase_wfuse(p, smem); }
        else run_peer_phase(p, l, sub - 4, smem, probe);
        return;
    }
    const int j = (ph - 20) / 8, sub = (ph - 20) % 8, l = 2 + j;
    if (sub == 0) {
        { EpiBf16<true> e{p.bufB, 1024, p.a_b_q + (size_t)j * 1024}; gemm_phase<3>(p.xn, DM, p.w_aq_t + (size_t)j * 1024 * 1024, DM, 1024, T_ALL, 1024, smem, e, rs_h, p.wv); }
        if (j == 0) { EpiF32<true> e{p.kv, 512, 0, p.a_b_kv}; gemm_phase<3>(p.xn, DM, p.w_kv_t, DM, 1024, T_ALL, 512, smem, e, rs_h, p.wv); }
    }
    else if (sub == 1) { phase_attn(p, j, smem); if (j == 0) phase_kvwin(p); }
    else if (sub == 2) { EpiResidual<true> e{p.h, p.h2, p.xn2, p.ssq_h2, p.a_b_o + (size_t)j * 1024};
                         gemm_phase<3>(p.bufB + (size_t)T_ALL * 1024, 1024, p.w_ao_t + (size_t)j * 1024 * 1024, 1024, 1024, T_ALL, 1024, smem, e, rs_none, p.wv); }
    else run_peer_phase(p, l, sub - 3, smem, probe);
}

#ifndef PROBE_MASK
#define PROBE_MASK 0
#endif
__device__ __forceinline__ int phase_kind(int ph) {
    if (ph == 0) return 0;
    if (ph == 1) return 14;
    if (ph == N_PHASES - 1) return 13;
    if (ph < 20) return 1 + (ph - 2) % 9;
    const int sub = (ph - 20) % 8;
    return sub < 3 ? 10 + sub : 5 + (sub - 3);
}
__global__ void __launch_bounds__(NTHREADS, 2) mega(Params pk) {
    Params p = pk; p.wv = __builtin_amdgcn_readfirstlane((int)(threadIdx.x >> 6));
    extern __shared__ __attribute__((aligned(16))) char smem[];
    volatile LAS unsigned* st = (volatile LAS unsigned*)(smem + DYN_LDS_BYTES - 16);
    if (lt(p.wv) == 0) { st[0] = 0u; st[1] = 0u; }
    __syncthreads();
    XcdBarrier xb = xcd_barrier_post(p.bar, st, p.wv);
    for (int ph = p.ph_lo; ph < p.ph_hi; ++ph) {
#if PROBE_MASK
        if ((PROBE_MASK >> phase_kind(ph)) & 1) { run_phase(p, ph, smem, true); xcd_barrier(xb); }
#endif
        if (ph == 1) continue;
        run_phase(p, ph, smem);
        if (ph + 1 < p.ph_hi) {
            xcd_barrier(xb);
        }
    }
}

extern "C" void kernel_launch(void* const* d_in, const int* in_sizes, int n_in, void* d_out, int out_size, void* d_ws, size_t ws_size, hipStream_t stream) {
    Params p{};
    const float* const* in = (const float* const*)d_in;
    p.x_prompt = in[0]; p.x_sample = in[1]; p.state_ssm = in[2]; p.state_conv = in[3]; p.cache_k = in[4]; p.cache_v = in[5];
    p.norm_mix = in[6]; p.norm_ffn = in[7]; p.norm_kv = in[8]; p.norm_final = in[9];
    p.m_w_in = in[10]; p.m_conv_w = in[11]; p.m_conv_b = in[12]; p.m_dt_bias = in[13]; p.m_a_log = in[14]; p.m_d_skip = in[15]; p.m_norm = in[16]; p.m_w_out = in[17];
    p.a_w_kv = in[18]; p.a_b_kv = in[19]; p.a_w_q = in[20]; p.a_b_q = in[21]; p.a_sinks = in[22]; p.a_w_o = in[23]; p.a_b_o = in[24];
    p.p_w_q = in[25]; p.p_sub_k1 = in[26]; p.p_sub_k2 = in[27]; p.p_u = in[28]; p.p_v = in[29];
    p.out = (float*)d_out;
    char* w = (char*)d_ws; size_t off = 0;
    auto take = [&](size_t bytes) { char* r = w + off; off += (bytes + 255) & ~(size_t)255; return r; };
    p.bar = (unsigned*)take(65536);
    p.w_in_t = (bf16_t*)take((size_t)2 * 6272 * 1024 * 2);
    p.w_out_t = (bf16_t*)take((size_t)2 * 1024 * 2048 * 2);
    p.w_kv_t = (bf16_t*)take((size_t)512 * 1024 * 2);
    p.w_aq_t = (bf16_t*)take((size_t)2 * 1024 * 1024 * 2);
    p.w_ao_t = (bf16_t*)take((size_t)2 * 1024 * 1024 * 2);
    p.w_pq_t = (bf16_t*)take((size_t)4 * 2048 * 1024 * 2);
    p.wq_b = (bf16_t*)take((size_t)4 * 1024 * 2048 * 2);
    p.subk = (bf16_t*)take((size_t)4 * 2 * 16384 * 2);
    p.u8 = (unsigned char*)take((size_t)4 * 16384 * 1024);
    p.v8 = (unsigned char*)take((size_t)4 * 16384 * 1024);
    p.h = (float*)take((size_t)T_ALL * 1024 * 4);
    p.h2 = (float*)take((size_t)T_ALL * 1024 * 4);
    p.xn = (bf16_t*)take((size_t)T_ALL * 1024 * 2);
    p.xn2 = (bf16_t*)take((size_t)T_ALL * 1024 * 2);
    p.bufA = (bf16_t*)take((size_t)T_ALL * 4096 * 2);
    p.bufB = (bf16_t*)take((size_t)T_ALL * 4096 * 2);
    p.zbuf = (bf16_t*)take((size_t)T_ALL * 2048 * 2);
    p.dtraw = (float*)take((size_t)T_ALL * 32 * 4);
    p.dtsp = (float*)take((size_t)T_ALL * 32 * 4);
    p.decay = (float*)take((size_t)T_ALL * 32 * 4);
    p.ybuf = (float*)take((size_t)T_ALL * 2048 * 4);
    p.eid = (int*)take((size_t)T_ALL * 128 * 4);
    p.gate = (float*)take((size_t)T_ALL * 128 * 4);
    p.wq = (unsigned char*)take((size_t)T_ALL * 128);
    p.wscale = (float*)take((size_t)T_ALL * 4);
    p.ssq_h = (float*)take((size_t)T_ALL * 8 * 4);
    p.ssq_h2 = (float*)take((size_t)T_ALL * 16 * 4);
    p.ssq_y = (float*)take((size_t)T_ALL * 64 * 4);
    p.partial = (float*)p.bufB;
    p.kv = (float*)(p.bufB + (size_t)T_ALL * 2048);
    if (off > ws_size) { fprintf(stderr, "kernel_launch: workspace too small: need %zu have %zu\n", off, ws_size); return; }
    static int grid = 0;
    if (grid == 0) {
        int dev = 0, cus = 0, per_cu = 0;
        (void)hipGetDevice(&dev);
        (void)hipDeviceGetAttribute(&cus, hipDeviceAttributeMultiprocessorCount, dev);
        (void)hipFuncSetAttribute((const void*)mega, hipFuncAttributeMaxDynamicSharedMemorySize, DYN_LDS_BYTES);
        (void)hipOccupancyMaxActiveBlocksPerMultiprocessor(&per_cu, (const void*)mega, NTHREADS, DYN_LDS_BYTES);
        if (per_cu > 2) per_cu = 2;
        if (per_cu < 1) per_cu = 1;
        grid = cus * per_cu;
    }
    (void)hipMemsetAsync(p.bar, 0, XCD_BAR_WORDS * 4, stream);
    p.ph_lo = 0; p.ph_hi = N_PHASES;
    void* args[] = {&p};
    hipError_t e = hipLaunchCooperativeKernel((const void*)mega, dim3(grid), dim3(NTHREADS), args, DYN_LDS_BYTES, stream);
    if (e != hipSuccess) fprintf(stderr, "cooperative launch failed: %s (grid %d)\n", hipGetErrorString(e), grid);
}
```

```cpp
#include <hip/hip_runtime.h>
#include <hip/hip_cooperative_groups.h>
#include <stdint.h>
#include <cstdio>

typedef unsigned short bf16_t;
typedef short bf16x8 __attribute__((ext_vector_type(8)));
typedef float f32x4 __attribute__((ext_vector_type(4)));
typedef unsigned u32x4 __attribute__((ext_vector_type(4)));
typedef unsigned u32x2 __attribute__((ext_vector_type(2)));
typedef float f32x2 __attribute__((ext_vector_type(2)));

#define T_P 16384
#define T_S 512
#define T_ALL 16896
#define DM 1024
#define NTHREADS 256
#define LAS __attribute__((address_space(3)))
#define SMEM_BYTES 65536
#define DYN_LDS_BYTES 81920

#define OFF_Y 0
#define OFF_PR_SSM 17301504
#define OFF_PR_CONV 21495808
#define OFF_PR_K 21692416
#define OFF_PR_V 21954560
#define OFF_SM_SSM 22216704
#define OFF_SM_CONV 38993920
#define OFF_SM_K 39780352
#define OFF_SM_V 40828928

struct Params {
    const float *x_prompt, *x_sample, *state_ssm, *state_conv, *cache_k, *cache_v;
    const float *norm_mix, *norm_ffn, *norm_kv, *norm_final;
    const float *m_w_in, *m_conv_w, *m_conv_b, *m_dt_bias, *m_a_log, *m_d_skip, *m_norm, *m_w_out;
    const float *a_w_kv, *a_b_kv, *a_w_q, *a_b_q, *a_sinks, *a_w_o, *a_b_o;
    const float *p_w_q, *p_sub_k1, *p_sub_k2, *p_u, *p_v;
    float* out;
    bf16_t *w_in_t, *w_out_t, *w_kv_t, *w_aq_t, *w_ao_t, *w_pq_t, *subk, *wq_b;
    unsigned char *u8, *v8;
    float* partial;
    unsigned char* wq;
    float* wscale;
    float *h, *h2;
    bf16_t *xn, *xn2, *bufA, *bufB, *zbuf;
    float *ssq_h, *ssq_h2, *ssq_y;
    float *dtsp, *decay, *dtraw, *ybuf, *kv;
    int* eid;
    float* gate;
    unsigned* bar;
    int ph_lo, ph_hi;
    int wv;
};

__device__ __forceinline__ float bf2f(bf16_t v) { return __uint_as_float(((unsigned)v) << 16); }
typedef float cvt_f32x2 __attribute__((ext_vector_type(2)));
typedef __bf16 cvt_bf16x2 __attribute__((ext_vector_type(2)));
__device__ __forceinline__ unsigned pk2(float lo, float hi) { const cvt_f32x2 f = {lo, hi}; return __builtin_bit_cast(unsigned, __builtin_convertvector(f, cvt_bf16x2)); }
__device__ __forceinline__ bf16_t f2bf(float f) { return (bf16_t)(pk2(f, f) & 0xffffu); }
__device__ __forceinline__ float bf_lo(unsigned u) { return __uint_as_float(u << 16); }
__device__ __forceinline__ float bf_hi(unsigned u) { return __uint_as_float(u & 0xffff0000u); }
__device__ __forceinline__ unsigned pk2_sw(float lo, float hi) { return pk2(lo, hi); }
template <int CTRL> __device__ __forceinline__ float dpp_mov(float v) { return __int_as_float(__builtin_amdgcn_update_dpp(0, __float_as_int(v), CTRL, 0xf, 0xf, true)); }
template <int CTRL> __device__ __forceinline__ int dpp_movi(int v) { return __builtin_amdgcn_update_dpp(0, v, CTRL, 0xf, 0xf, true); }
__device__ __forceinline__ float row_sum16(float v) {
    v += dpp_mov<0xB1>(v); v += dpp_mov<0x4E>(v); v += dpp_mov<0x141>(v); v += dpp_mov<0x140>(v); return v;
}
__device__ __forceinline__ float xor16_sum(float v) { const auto r = __builtin_amdgcn_permlane16_swap(__float_as_uint(v), __float_as_uint(v), false, false); return __uint_as_float(r[0]) + __uint_as_float(r[1]); }
__device__ __forceinline__ float xor32_sum(float v) { const auto r = __builtin_amdgcn_permlane32_swap(__float_as_uint(v), __float_as_uint(v), false, false); return __uint_as_float(r[0]) + __uint_as_float(r[1]); }
__device__ __forceinline__ float xor16_max(float v) { const auto r = __builtin_amdgcn_permlane16_swap(__float_as_uint(v), __float_as_uint(v), false, false); return fmaxf(__uint_as_float(r[0]), __uint_as_float(r[1])); }
__device__ __forceinline__ float xor32_max(float v) { const auto r = __builtin_amdgcn_permlane32_swap(__float_as_uint(v), __float_as_uint(v), false, false); return fmaxf(__uint_as_float(r[0]), __uint_as_float(r[1])); }
__device__ __forceinline__ float wave_sum(float v) { return xor32_sum(xor16_sum(row_sum16(v))); }
__device__ __forceinline__ unsigned pack_fp8x4(float a, float b, float c, float d) {
    int w = 0; w = __builtin_amdgcn_cvt_pk_fp8_f32(a, b, w, false); w = __builtin_amdgcn_cvt_pk_fp8_f32(c, d, w, true); return (unsigned)w;
}
__device__ __forceinline__ unsigned pack_i8x4(float a, float b, float c, float d) {
    const int ia = max(-127, min(127, __float2int_rn(a))), ib = max(-127, min(127, __float2int_rn(b))), ic = max(-127, min(127, __float2int_rn(c))), id = max(-127, min(127, __float2int_rn(d)));
    return (unsigned)(ia & 255) | ((unsigned)(ib & 255) << 8) | ((unsigned)(ic & 255) << 16) | ((unsigned)(id & 255) << 24);
}
__device__ __forceinline__ int lt(int wv) { int t; asm volatile("v_mbcnt_lo_u32_b32 %0, -1, 0\n\tv_mbcnt_hi_u32_b32 %0, -1, %0\n\tv_lshl_or_b32 %0, %1, 6, %0" : "=&v"(t) : "s"(wv)); return t; }
__device__ __forceinline__ int lb() { int b = blockIdx.x; asm volatile("" : "+s"(b)); return b; }
#define TIDX lt(p.wv)
#define BIDX lb()
__device__ __forceinline__ float silu_f(float x) { return x * __builtin_amdgcn_rcpf(1.f + __expf(-x)); }
__device__ __forceinline__ float gelu_tanh(float x) {
    const float u = 0.7978845608028654f * (x + 0.044715f * x * x * x);
    const float t = 1.f - 2.f * __builtin_amdgcn_rcpf(__expf(2.f * u) + 1.f);
    return 0.5f * x * (1.f + t);
}

__device__ __forceinline__ void convert_tables(const Params& p, int l0, int nl, size_t vtid, size_t vstride) {
    const size_t np = (size_t)nl * 16384 * 64, base = (size_t)l0 * 16384 * 64;
    const int jfix = (int)(vtid & 63);
    f32x4 gu[2][4];
#pragma unroll
    for (int li = 0; li < 2; ++li)
#pragma unroll
        for (int k = 0; k < 4; ++k) gu[li][k] = *(const f32x4*)(p.norm_ffn + (size_t)(l0 + min(li, nl - 1)) * 1024 + 16 * jfix + 4 * k) * 512.f;
    for (size_t i0 = vtid; i0 < 2 * np; i0 += 4 * vstride) {
        f32x4 a[4][4]; bool ok[4];
#pragma unroll
        for (int u = 0; u < 4; ++u) {
            const size_t i = i0 + (size_t)u * vstride; ok[u] = i < 2 * np;
            if (ok[u]) {
                const bool isv = i >= np; const size_t q = base + (isv ? i - np : i);
                const float* s = (isv ? p.p_v : p.p_u) + (q >> 6) * 1024 + 16 * (q & 63);
#pragma unroll
                for (int k = 0; k < 4; ++k) a[u][k] = __builtin_nontemporal_load((const f32x4*)(s + 4 * k));
            }
        }
#pragma unroll
        for (int u = 0; u < 4; ++u) {
            const size_t i = i0 + (size_t)u * vstride;
            if (ok[u]) {
                const bool isv = i >= np; const size_t q = base + (isv ? i - np : i);
                const int j = (int)(q & 63), e = (int)((q >> 6) & 16383), l = (int)(q >> 20);
                f32x4 g[4];
#pragma unroll
                for (int k = 0; k < 4; ++k) g[k] = isv ? (f32x4){256.f, 256.f, 256.f, 256.f} : (l > l0 ? gu[1][k] : gu[0][k]);
                u32x4 o;
                { const f32x4 v = a[u][0] * g[0]; o.x = pack_i8x4(v.x, v.y, v.z, v.w); }
                { const f32x4 v = a[u][1] * g[1]; o.y = pack_i8x4(v.x, v.y, v.z, v.w); }
                { const f32x4 v = a[u][2] * g[2]; o.z = pack_i8x4(v.x, v.y, v.z, v.w); }
                { const f32x4 v = a[u][3] * g[3]; o.w = pack_i8x4(v.x, v.y, v.z, v.w); }
                unsigned char* dst = (isv ? p.v8 : p.u8) + (((size_t)l * 8 + (j >> 3)) * 16384 + e) * 128 + 16 * (j & 7);
                *(u32x4*)dst = o;
            }
        }
    }
}

struct TJob { const float* src; bf16_t* dst; int K, N, Npad; const float* gk; };
__device__ __forceinline__ TJob get_tjob(const Params& p, int j) {
    TJob t;
    if (j < 2) { t.src = p.m_w_in + (size_t)j * 1024 * 6176; t.dst = p.w_in_t + (size_t)j * 6272 * 1024; t.K = 1024; t.N = 6176; t.Npad = 6272; t.gk = p.norm_mix + (size_t)j * 1024; }
    else if (j < 4) { t.src = p.m_w_out + (size_t)(j - 2) * 2048 * 1024; t.dst = p.w_out_t + (size_t)(j - 2) * 1024 * 2048; t.K = 2048; t.N = 1024; t.Npad = 1024; t.gk = p.m_norm + (size_t)(j - 2) * 2048; }
    else if (j < 5) { t.src = p.a_w_kv; t.dst = p.w_kv_t; t.K = 1024; t.N = 512; t.Npad = 512; t.gk = p.norm_kv; }
    else if (j < 7) { t.src = p.a_w_q + (size_t)(j - 5) * 1024 * 1024; t.dst = p.w_aq_t + (size_t)(j - 5) * 1024 * 1024; t.K = 1024; t.N = 1024; t.Npad = 1024; t.gk = p.norm_mix + (size_t)(2 + j - 5) * 1024; }
    else if (j < 9) { t.src = p.a_w_o + (size_t)(j - 7) * 1024 * 1024; t.dst = p.w_ao_t + (size_t)(j - 7) * 1024 * 1024; t.K = 1024; t.N = 1024; t.Npad = 1024; t.gk = nullptr; }
    else { t.src = p.p_w_q + (size_t)(j - 9) * 1024 * 2048; t.dst = p.w_pq_t + (size_t)(j - 9) * 2048 * 1024; t.K = 1024; t.N = 2048; t.Npad = 2048; t.gk = p.norm_ffn + (size_t)(j - 9) * 1024; }
    return t;
}
#define N_TJOBS 9

__device__ __forceinline__ void convert_transposes(const Params& p, char* smem, int j0, int j1, int vb, int vG) {
    const int tid = TIDX;
    float* scr = (float*)smem;
    int total = 0;
    for (int j = j0; j < j1; ++j) { TJob t = get_tjob(p, j); total += (t.K / 64) * (t.Npad / 64); }
    for (int tile = vb; tile < total; tile += vG) {
        int r = tile, j = j0; TJob t = get_tjob(p, j0);
        for (;;) { const int n = (t.K / 64) * (t.Npad / 64); if (r < n) break; r -= n; ++j; t = get_tjob(p, j); }
        const int nnt = t.Npad / 64, kt = r / nnt, nt = r % nnt, k0 = kt * 64, n0 = nt * 64;
        __syncthreads();
        const float* gkp = t.gk ? t.gk : p.norm_mix;
        const bool has_g = t.gk != nullptr;
        float xv[16], gv[16];
#pragma unroll
        for (int i = 0; i < 16; ++i) {
            const int e = tid + 256 * i, kk = e >> 6, nn = e & 63;
            xv[i] = t.src[(size_t)(k0 + kk) * t.N + min(n0 + nn, t.N - 1)];
            gv[i] = gkp[k0 + kk];
        }
#pragma unroll
        for (int i = 0; i < 16; ++i) {
            const int e = tid + 256 * i, kk = e >> 6, nn = e & 63;
            const float v = xv[i] * (has_g ? gv[i] : 1.f);
            scr[kk * 65 + nn] = (n0 + nn < t.N) ? v : 0.f;
        }
        __syncthreads();
#pragma unroll
        for (int i = 0; i < 2; ++i) {
            const int e = tid + 256 * i, nn = e >> 3, c = e & 7;
            const float* s = scr + (8 * c) * 65 + nn;
            u32x4 o; o.x = pk2(s[0], s[65]); o.y = pk2(s[130], s[195]); o.z = pk2(s[260], s[325]); o.w = pk2(s[390], s[455]);
            *(u32x4*)(t.dst + (size_t)(n0 + nn) * t.K + k0 + 8 * c) = o;
        }
    }
}
__device__ __forceinline__ void phase_convert(const Params& p, char* smem) { convert_transposes(p, smem, 0, 1, BIDX, gridDim.x); }
__device__ __forceinline__ void convert_plain(const Params& p, size_t gtid, size_t gstride) {
    {
        const size_t n8 = (size_t)4 * 2 * 16384 / 8;
        for (size_t i = gtid; i < n8; i += gstride) {
            const size_t e = i * 8; const int l = (int)(e / 32768), hf = (int)((e / 16384) & 1); const size_t off = e & 16383;
            const float* s = (hf ? p.p_sub_k2 : p.p_sub_k1) + (size_t)l * 16384 + off;
            const f32x4 a = *(const f32x4*)s, b = *(const f32x4*)(s + 4);
            u32x4 o; o.x = pk2(a.x, a.y); o.y = pk2(a.z, a.w); o.z = pk2(b.x, b.y); o.w = pk2(b.z, b.w);
            *(u32x4*)(p.subk + e) = o;
        }
    }
    {
        const size_t n8 = (size_t)4 * 1024 * 2048 / 8;
        for (size_t i = gtid; i < n8; i += 4 * gstride) {
            f32x4 a[4], b[4]; float g[4];
#pragma unroll
            for (int u = 0; u < 4; ++u) {
                const size_t e = min(i + u * gstride, n8 - 1) * 8;
                g[u] = p.norm_ffn[e >> 11]; a[u] = *(const f32x4*)(p.p_w_q + e); b[u] = *(const f32x4*)(p.p_w_q + e + 4);
            }
#pragma unroll
            for (int u = 0; u < 4; ++u) {
                if (i + u * gstride < n8) {
                    const size_t e = (i + u * gstride) * 8;
                    const f32x4 av = a[u] * g[u], bv = b[u] * g[u];
                    u32x4 o; o.x = pk2(av.x, av.y); o.y = pk2(av.z, av.w); o.z = pk2(bv.x, bv.y); o.w = pk2(bv.z, bv.w);
                    *(u32x4*)(p.wq_b + e) = o;
                }
            }
        }
    }
}

__device__ __forceinline__ void wave_rmsnorm_store(const f32x4 (&v)[4], const float* g, bf16_t* dst, int lane) {
    float ss = 0.f;
#pragma unroll
    for (int i = 0; i < 4; ++i) ss += v[i].x * v[i].x + v[i].y * v[i].y + v[i].z * v[i].z + v[i].w * v[i].w;
    ss = wave_sum(ss);
    const float inv = rsqrtf(ss * (1.f / 1024.f) + 1e-6f);
#pragma unroll
    for (int i = 0; i < 4; ++i) {
        const f32x4 gv = *(const f32x4*)(g + i * 256 + lane * 4);
        u32x2 o; o.x = pk2(v[i].x * inv * gv.x, v[i].y * inv * gv.y); o.y = pk2(v[i].z * inv * gv.z, v[i].w * inv * gv.w);
        *(u32x2*)(dst + i * 256 + lane * 4) = o;
    }
}

__device__ __forceinline__ void phase_embed(const Params& p) {
    const int lane = TIDX & 63, gw = BIDX * 4 + p.wv, nw = gridDim.x * 4;
    for (int row0 = gw; row0 < T_ALL; row0 += 2 * nw) {
        f32x4 v[2][4];
#pragma unroll
        for (int u = 0; u < 2; ++u) {
            const int row = min(row0 + u * nw, T_ALL - 1);
            const float* src = row < T_P ? p.x_prompt + (size_t)row * DM : p.x_sample + (size_t)(row - T_P) * DM;
#pragma unroll
            for (int i = 0; i < 4; ++i) v[u][i] = *(const f32x4*)(src + i * 256 + lane * 4);
        }
#pragma unroll
        for (int u = 0; u < 2; ++u) {
            const int row = row0 + u * nw;
            if (row < T_ALL) {
                float ss = 0.f;
#pragma unroll
                for (int i = 0; i < 4; ++i) {
                    const f32x4 x = v[u][i];
                    *(f32x4*)(p.h + (size_t)row * DM + i * 256 + lane * 4) = x;
                    u32x2 o; o.x = pk2(x.x, x.y); o.y = pk2(x.z, x.w);
                    *(u32x2*)(p.xn + (size_t)row * DM + i * 256 + lane * 4) = o;
                    ss += x.x * x.x + x.y * x.y + x.z * x.z + x.w * x.w;
                }
                ss = wave_sum(ss);
                if (lane < 8) p.ssq_h[(size_t)row * 8 + lane] = lane == 0 ? ss : 0.f;
            }
        }
    }
}

__device__ __forceinline__ int lds_off(int r, int c) { return r * 128 + ((c ^ ((r >> 1) & 7)) << 4); }

struct RowScale { const float* part; int nparts; float inv_dim; };
template <int MFR, class Epi>
__device__ __forceinline__ void gemm_tile(const bf16_t* __restrict__ A, int lda, const bf16_t* __restrict__ Bt, int ldb, int K,
                                          int m0, int n0, char* smem, const Epi& epi, const RowScale& rs, int wv, bool first = true, bool has_next = false, int m0n = 0, int n0n = 0) {
    const int tid = lt(wv), lane = tid & 63, wid = wv, wm = wid >> 1, wn = wid & 1;
    constexpr int AB = MFR > 4 ? MFR * 4096 : 16384, STG = AB + 16384;
    f32x4 acc[4][MFR];
#pragma unroll
    for (int a = 0; a < 4; ++a)
#pragma unroll
        for (int b = 0; b < MFR; ++b) acc[a][b] = (f32x4){0.f, 0.f, 0.f, 0.f};
    const int nk = K / 64;
    const int srow = wid * 8 + (lane >> 3), schunk = (lane & 7) ^ ((srow >> 1) & 7);
    const bf16_t* ga = A + (size_t)(m0 + srow) * lda + schunk * 8;
    const bf16_t* gb = Bt + (size_t)(n0 + srow) * ldb + schunk * 8;
    auto stage2 = [&](const bf16_t* ga, const bf16_t* gb, int kt, char* buf) {
#pragma unroll
        for (int i = 0; i < (MFR > 4 ? MFR : 4); ++i) {
            if (i < MFR) __builtin_amdgcn_global_load_lds((const unsigned*)(ga + (size_t)(32 * i) * lda + kt * 64), (LAS unsigned*)(buf + (4 * i + wid) * 1024), 16, 0, 0);
            if (i < 4) __builtin_amdgcn_global_load_lds((const unsigned*)(gb + (size_t)(32 * i) * ldb + kt * 64), (LAS unsigned*)(buf + AB + (4 * i + wid) * 1024), 16, 0, 0);
        }
    };
    auto stage = [&](int kt, char* buf) { stage2(ga, gb, kt, buf); };
    bf16x8 xf[2][MFR], wf[2][4];
    auto rd = [&](int fb, const char* cur, int kk) {
        const int c = kk * 4 + (lane >> 4);
#pragma unroll
        for (int im = 0; im < MFR; ++im) xf[fb][im] = *(const bf16x8*)(cur + lds_off(wm * (16 * MFR) + im * 16 + (lane & 15), c));
#pragma unroll
        for (int jn = 0; jn < 4; ++jn) wf[fb][jn] = *(const bf16x8*)(cur + AB + lds_off(wn * 64 + jn * 16 + (lane & 15), c));
    };
    auto mm = [&](int fb, int j0, int j1) {
#pragma unroll
        for (int jn = j0; jn < j1; ++jn)
#pragma unroll
            for (int im = 0; im < MFR; ++im) acc[jn][im] = __builtin_amdgcn_mfma_f32_16x16x32_bf16(wf[fb][jn], xf[fb][im], acc[jn][im], 0, 0, 0);
    };
    if (first) {
        __syncthreads();
        stage(0, smem);
        asm volatile("s_waitcnt vmcnt(0)" ::: "memory");
        __syncthreads();
        if (nk > 1) stage(1, smem + STG);
    } else {
        asm volatile("s_waitcnt vmcnt(0)" ::: "memory");
        __syncthreads();
    }
    rd(0, smem, 0);
    for (int kt = 0; kt < nk; ++kt) {
        char* cur = smem + (kt & 1) * STG;
        char* nxt = smem + ((kt + 1) & 1) * STG;
        mm(0, 0, 1);
        __builtin_amdgcn_sched_barrier(0);
        rd(1, cur, 1);
        __builtin_amdgcn_sched_barrier(0);
        mm(0, 1, 4);
        __builtin_amdgcn_sched_barrier(0);
        asm volatile("s_waitcnt vmcnt(0) lgkmcnt(0)" ::: "memory");
        __syncthreads();
        if (kt + 2 < nk) stage(kt + 2, cur);
        else if (has_next) { const int tl = lt(wv), sr = wv * 8 + ((tl & 63) >> 3), sc = (tl & 7) ^ ((sr >> 1) & 7);
                             stage2(A + (size_t)(m0n + sr) * lda + sc * 8, Bt + (size_t)(n0n + sr) * ldb + sc * 8, kt + 2 - nk, cur); }
        if (kt + 1 < nk) rd(0, nxt, 0);
        __builtin_amdgcn_sched_barrier(0);
        mm(1, 0, 4);
        __builtin_amdgcn_sched_barrier(0);
    }
    f32x4 addv[Epi::kHasPre ? 4 : 1][Epi::kHasPre ? MFR : 1];
    if (Epi::kHasPre) {
#pragma unroll
        for (int im = 0; im < MFR; ++im)
#pragma unroll
            for (int jn = 0; jn < 4; ++jn) addv[Epi::kHasPre ? jn : 0][Epi::kHasPre ? im : 0] = epi.pre(m0 + wm * (16 * MFR) + im * 16 + (lane & 15), n0 + wn * 64 + jn * 16 + (lane >> 4) * 4);
        __builtin_amdgcn_sched_barrier(0);
    }
    float rsc[MFR > 4 ? MFR : 4];
#pragma unroll
    for (int i = 0; i < (MFR > 4 ? MFR : 4); ++i) rsc[i] = 1.f;
    if (rs.part) {
        const int per = rs.nparts >> 2;
        f32x2 pvv[MFR][4];
#pragma unroll
        for (int im = 0; im < MFR; ++im) {
            const float* pp = rs.part + (size_t)(m0 + wm * (16 * MFR) + im * 16 + (lane & 15)) * rs.nparts + (lane >> 4) * per;
#pragma unroll
            for (int q = 0; q < 4; ++q) pvv[im][q] = *(const f32x2*)(pp + min(2 * q, per - 2));
        }
        __builtin_amdgcn_sched_barrier(0);
#pragma unroll
        for (int im = 0; im < MFR; ++im) {
            float sm = 0.f;
#pragma unroll
            for (int q = 0; q < 4; ++q) sm += (2 * q < per) ? pvv[im][q].x + pvv[im][q].y : 0.f;
            sm = xor32_sum(xor16_sum(sm));
            rsc[im] = rsqrtf(sm * rs.inv_dim + 1e-6f);
        }
    }
    if (Epi::kResPack) {
        const int q4 = lane >> 4;
#pragma unroll
        for (int im = 0; im < MFR; ++im) {
            const int m = m0 + wm * (16 * MFR) + im * 16 + (lane & 15);
            f32x4 o[4]; float ss = 0.f;
#pragma unroll
            for (int jn = 0; jn < 4; ++jn) { o[jn] = epi.res4(m, n0 + wn * 64 + jn * 16 + q4 * 4, acc[jn][im] * rsc[im], addv[Epi::kHasPre ? jn : 0][Epi::kHasPre ? im : 0]); ss += (o[jn].x * o[jn].x + o[jn].y * o[jn].y) + (o[jn].z * o[jn].z + o[jn].w * o[jn].w); }
#pragma unroll
            for (int jp = 0; jp < 2; ++jp) {
                const unsigned ax = pk2(o[2 * jp].x, o[2 * jp].y), ay = pk2(o[2 * jp].z, o[2 * jp].w), bx = pk2(o[2 * jp + 1].x, o[2 * jp + 1].y), by = pk2(o[2 * jp + 1].z, o[2 * jp + 1].w);
                const auto s0 = __builtin_amdgcn_permlane16_swap(ax, bx, false, false), s1 = __builtin_amdgcn_permlane16_swap(ay, by, false, false);
                const u32x4 w = {s0[0], s1[0], s0[1], s1[1]};
                epi.store16(m, n0 + wn * 64 + (2 * jp + (q4 & 1)) * 16 + (q4 & 2) * 4, w);
            }
            ss = xor32_sum(xor16_sum(ss)); if (q4 == 0) epi.put_ss(m, (n0 >> 7) * 2 + wn, ss);
        }
        return;
    }
    if (Epi::kPack16 && epi.pack_ok(n0)) {
        const int q4 = lane >> 4;
#pragma unroll
        for (int im = 0; im < MFR; ++im) {
            const int m = m0 + wm * (16 * MFR) + im * 16 + (lane & 15);
#pragma unroll
            for (int jp = 0; jp < 2; ++jp) {
                const u32x2 a = epi.pack4(acc[2 * jp][im] * rsc[im], addv[Epi::kHasPre ? 2 * jp : 0][Epi::kHasPre ? im : 0]), b = epi.pack4(acc[2 * jp + 1][im] * rsc[im], addv[Epi::kHasPre ? 2 * jp + 1 : 0][Epi::kHasPre ? im : 0]);
                const auto s0 = __builtin_amdgcn_permlane16_swap(a.x, b.x, false, false), s1 = __builtin_amdgcn_permlane16_swap(a.y, b.y, false, false);
                const u32x4 w = {s0[0], s1[0], s0[1], s1[1]};
                epi.store16(m, n0 + wn * 64 + (2 * jp + (q4 & 1)) * 16 + (q4 & 2) * 4, w);
            }
        }
        return;
    }
#pragma unroll
    for (int im = 0; im < MFR; ++im) {
        const int m = m0 + wm * (16 * MFR) + im * 16 + (lane & 15);
        float ss = 0.f;
#pragma unroll
        for (int jn = 0; jn < 4; ++jn) ss += epi.store4(m, n0 + wn * 64 + jn * 16 + (lane >> 4) * 4, acc[jn][im] * rsc[im], addv[Epi::kHasPre ? jn : 0][Epi::kHasPre ? im : 0]);
        if (Epi::kWantSS) { ss = xor32_sum(xor16_sum(ss)); if ((lane >> 4) == 0) epi.put_ss(m, (n0 >> 7) * 2 + wn, ss); }
    }
}

template <int MFR, class Epi>
__device__ __forceinline__ void gemm_phase(const bf16_t* A, int lda, const bf16_t* Bt, int ldb, int K, int M, int N, char* smem, const Epi& epi, const RowScale& rs, int wv) {
    const int mt = M / (32 * MFR), nt = N / 128, nwg = mt * nt, G = gridDim.x, bid = BIDX;
    auto tile_of = [&](int L, int& im, int& in) {
        int wgid;
        { const int q = nwg >> 3, r = nwg & 7, xcd = L & 7, off = L >> 3; wgid = (xcd < r ? xcd * (q + 1) : r * (q + 1) + (xcd - r) * q) + off; }
        const int nig = 8 * nt, gid = wgid / nig, fm = gid * 8, gsz = (mt - fm) < 8 ? (mt - fm) : 8;
        im = fm + ((wgid % nig) % gsz); in = (wgid % nig) / gsz;
    };
    for (int L = bid; L < nwg; L += G) {
        int im, in, imn = 0, inn = 0;
        tile_of(L, im, in);
        const bool has_next = L + G < nwg;
        if (has_next) tile_of(L + G, imn, inn);
        gemm_tile<MFR>(A, lda, Bt, ldb, K, im * 32 * MFR, in * 128, smem, epi, rs, wv, L == bid, has_next, imn * 32 * MFR, inn * 128);
    }
    if (MFR > 4) { __syncthreads(); if (lt(wv) == 0) { volatile LAS unsigned* stw = (volatile LAS unsigned*)(smem + DYN_LDS_BYTES - 16); stw[0] = 0u; stw[1] = 0u; } }
}

struct EpiInProj {
    static constexpr bool kWantSS = false, kHasPre = false, kHasBias = false, kPack16 = true, kResPack = false;
    bf16_t* z; bf16_t* xbc; float* dtraw;
    __device__ __forceinline__ f32x4 pre(int, int) const { return (f32x4){0.f, 0.f, 0.f, 0.f}; }
    __device__ __forceinline__ bool pack_ok(int n0) const { return n0 < 6144; }
    __device__ __forceinline__ f32x4 res4(int, int, const f32x4& v, const f32x4&) const { return v; }
    __device__ __forceinline__ u32x2 pack4(const f32x4& v, const f32x4&) const { u32x2 o; o.x = pk2(v.x, v.y); o.y = pk2(v.z, v.w); return o; }
    __device__ __forceinline__ void store16(int m, int n, const u32x4& w) const {
        if (n < 2048) *(u32x4*)(z + (size_t)m * 2048 + n) = w; else *(u32x4*)(xbc + (size_t)m * 4096 + (n - 2048)) = w;
    }
    __device__ __forceinline__ float store4(int m, int n, const f32x4& v, const f32x4&) const {
        if (n < 2048) { u32x2 o; o.x = pk2(v.x, v.y); o.y = pk2(v.z, v.w); *(u32x2*)(z + (size_t)m * 2048 + n) = o; }
        else if (n < 6144) { u32x2 o; o.x = pk2(v.x, v.y); o.y = pk2(v.z, v.w); *(u32x2*)(xbc + (size_t)m * 4096 + (n - 2048)) = o; }
        else if (n < 6176) { *(f32x4*)(dtraw + (size_t)m * 32 + (n - 6144)) = v; }
        return 0.f;
    }
    __device__ __forceinline__ void put_ss(int, int, float) const {}
};
template <bool HB>
struct EpiResidual {
    static constexpr bool kWantSS = true, kHasPre = true, kHasBias = false, kPack16 = false, kResPack = true;
    __device__ __forceinline__ bool pack_ok(int) const { return false; }
    __device__ __forceinline__ u32x2 pack4(const f32x4&, const f32x4&) const { return (u32x2){0u, 0u}; }
    __device__ __forceinline__ f32x4 res4(int m, int n, const f32x4& v, const f32x4& add) const { const f32x4 o = add + v; *(f32x4*)(hout + (size_t)m * DM + n) = o; return o; }
    __device__ __forceinline__ void store16(int m, int n, const u32x4& w) const { *(u32x4*)(hb + (size_t)m * DM + n) = w; }
    const float* hin; float* hout; bf16_t* hb; float* ssq; const float* bias;
    __device__ __forceinline__ f32x4 pre(int m, int n) const {
        const f32x4 r = *(const f32x4*)(hin + (size_t)m * DM + n);
        if (HB) return r + *(const f32x4*)(bias + n);
        return r;
    }
    __device__ __forceinline__ float store4(int m, int n, const f32x4& v, const f32x4& add) const {
        f32x4 o = add + v;
        *(f32x4*)(hout + (size_t)m * DM + n) = o;
        u32x2 w; w.x = pk2(o.x, o.y); w.y = pk2(o.z, o.w);
        *(u32x2*)(hb + (size_t)m * DM + n) = w;
        return (o.x * o.x + o.y * o.y) + (o.z * o.z + o.w * o.w);
    }
    __device__ __forceinline__ void put_ss(int m, int idx, float ss) const { ssq[(size_t)m * 16 + idx] = ss; }
};
template <bool HB>
struct EpiBf16 {
    static constexpr bool kWantSS = false, kHasPre = HB, kHasBias = false, kPack16 = true, kResPack = false;
    bf16_t* out; int ld; const float* bias;
    __device__ __forceinline__ bool pack_ok(int) const { return true; }
    __device__ __forceinline__ f32x4 res4(int, int, const f32x4& v, const f32x4&) const { return v; }
    __device__ __forceinline__ u32x2 pack4(const f32x4& v, const f32x4& add) const { f32x4 q = v; if (HB) q += add; u32x2 o; o.x = pk2(q.x, q.y); o.y = pk2(q.z, q.w); return o; }
    __device__ __forceinline__ void store16(int m, int n, const u32x4& w) const { *(u32x4*)(out + (size_t)m * ld + n) = w; }
    __device__ __forceinline__ f32x4 pre(int, int n) const { if (HB) return *(const f32x4*)(bias + n); return (f32x4){0.f, 0.f, 0.f, 0.f}; }
    __device__ __forceinline__ float store4(int m, int n, const f32x4& v, const f32x4& add) const {
        f32x4 o = v; if (HB) o += add;
        u32x2 w; w.x = pk2(o.x, o.y); w.y = pk2(o.z, o.w);
        *(u32x2*)(out + (size_t)m * ld + n) = w;
        return 0.f;
    }
    __device__ __forceinline__ void put_ss(int, int, float) const {}
};
struct EpiTransBf16 {
    static constexpr bool kWantSS = false, kHasPre = false, kHasBias = false, kPack16 = false, kResPack = false;
    bf16_t* out; int ld;
    __device__ __forceinline__ bool pack_ok(int) const { return false; }
    __device__ __forceinline__ f32x4 res4(int, int, const f32x4& v, const f32x4&) const { return v; }
    __device__ __forceinline__ u32x2 pack4(const f32x4&, const f32x4&) const { return (u32x2){0u, 0u}; }
    __device__ __forceinline__ void store16(int, int, const u32x4&) const {}
    __device__ __forceinline__ f32x4 pre(int, int) const { return (f32x4){0.f, 0.f, 0.f, 0.f}; }
    __device__ __forceinline__ float store4(int m, int n, const f32x4& v, const f32x4&) const {
        const unsigned a = pk2_sw(v.x, v.y), b = pk2_sw(v.z, v.w);
        out[(size_t)n * ld + m] = (bf16_t)(a & 0xffffu); out[(size_t)(n + 1) * ld + m] = (bf16_t)(a >> 16); out[(size_t)(n + 2) * ld + m] = (bf16_t)(b & 0xffffu); out[(size_t)(n + 3) * ld + m] = (bf16_t)(b >> 16);
        return 0.f;
    }
    __device__ __forceinline__ void put_ss(int, int, float) const {}
};
template <bool HB>
struct EpiF32 {
    static constexpr bool kWantSS = false, kHasPre = HB, kHasBias = false, kPack16 = false, kResPack = false;
    float* out; int ld; int coloff; const float* bias;
    __device__ __forceinline__ bool pack_ok(int) const { return false; }
    __device__ __forceinline__ f32x4 res4(int, int, const f32x4& v, const f32x4&) const { return v; }
    __device__ __forceinline__ u32x2 pack4(const f32x4&, const f32x4&) const { return (u32x2){0u, 0u}; }
    __device__ __forceinline__ void store16(int, int, const u32x4&) const {}
    __device__ __forceinline__ f32x4 pre(int, int n) const { if (HB) return *(const f32x4*)(bias + n); return (f32x4){0.f, 0.f, 0.f, 0.f}; }
    __device__ __forceinline__ float store4(int m, int n, const f32x4& v, const f32x4& add) const {
        f32x4 o = v; if (HB) o += add;
        *(f32x4*)(out + (size_t)m * ld + coloff + n) = o;
        return 0.f;
    }
    __device__ __forceinline__ void put_ss(int, int, float) const {}
};

__device__ __forceinline__ void phase_conv(const Params& p, int l) {
    const size_t gtid = (size_t)BIDX * NTHREADS + TIDX, gstride = (size_t)gridDim.x * NTHREADS;
    const float* cw = p.m_conv_w + (size_t)l * 4 * 4096;
    const float* cb = p.m_conv_b + (size_t)l * 4096;
    const bf16_t* xr = p.bufA;
    bf16_t* xc = p.bufB;
    const size_t nitems = (size_t)(T_ALL / 4) * 512;
    const int c0 = (int)(gtid & 511) * 8;
    float wk[4][8], bias[8];
    {
#pragma unroll
        for (int k = 0; k < 4; ++k) {
            const f32x4 w0 = *(const f32x4*)(cw + k * 4096 + c0), w1 = *(const f32x4*)(cw + k * 4096 + c0 + 4);
            wk[k][0] = w0.x; wk[k][1] = w0.y; wk[k][2] = w0.z; wk[k][3] = w0.w; wk[k][4] = w1.x; wk[k][5] = w1.y; wk[k][6] = w1.z; wk[k][7] = w1.w;
        }
        const f32x4 b0 = *(const f32x4*)(cb + c0), b1 = *(const f32x4*)(cb + c0 + 4);
        bias[0] = b0.x; bias[1] = b0.y; bias[2] = b0.z; bias[3] = b0.w; bias[4] = b1.x; bias[5] = b1.y; bias[6] = b1.z; bias[7] = b1.w;
    }
    auto ldrows = [&](size_t it, u32x4 (&raw)[7]) {
        const int t0 = (int)(it >> 9) * 4;
#pragma unroll
        for (int r = 0; r < 7; ++r) raw[r] = *(const u32x4*)(xr + (size_t)max(t0 - 3 + r, 0) * 4096 + c0);
    };
    auto compute = [&](size_t it, const u32x4 (&raw)[7]) {
        const int t0 = (int)(it >> 9) * 4;
        int b, pos0, L; const float* prev = nullptr; float* cso;
        if (t0 < T_P) { b = t0 >> 11; pos0 = t0 & 2047; L = 2048; cso = p.out + OFF_PR_CONV + ((size_t)l * 8 + b) * 3 * 4096; }
        else { const int ts = t0 - T_P; b = ts >> 4; pos0 = ts & 15; L = 16; prev = p.state_conv + ((size_t)l * 32 + b) * 3 * 4096; cso = p.out + OFF_SM_CONV + ((size_t)l * 32 + b) * 3 * 4096; }
        float xv[7][8];
#pragma unroll
        for (int r = 0; r < 7; ++r) {
            const u32x4 u = raw[r];
            xv[r][0] = bf_lo(u.x); xv[r][1] = bf_hi(u.x); xv[r][2] = bf_lo(u.y); xv[r][3] = bf_hi(u.y); xv[r][4] = bf_lo(u.z); xv[r][5] = bf_hi(u.z); xv[r][6] = bf_lo(u.w); xv[r][7] = bf_hi(u.w);
        }
        if (pos0 == 0) {
#pragma unroll
            for (int r = 0; r < 3; ++r) {
                if (prev) {
                    const f32x4 a = *(const f32x4*)(prev + (size_t)r * 4096 + c0), bq = *(const f32x4*)(prev + (size_t)r * 4096 + c0 + 4);
                    xv[r][0] = a.x; xv[r][1] = a.y; xv[r][2] = a.z; xv[r][3] = a.w; xv[r][4] = bq.x; xv[r][5] = bq.y; xv[r][6] = bq.z; xv[r][7] = bq.w;
                } else {
#pragma unroll
                    for (int j = 0; j < 8; ++j) xv[r][j] = 0.f;
                }
            }
        }
#pragma unroll
        for (int o4 = 0; o4 < 4; ++o4) {
            float acc[8];
#pragma unroll
            for (int j = 0; j < 8; ++j) acc[j] = bias[j] + xv[o4][j] * wk[0][j] + xv[o4 + 1][j] * wk[1][j] + xv[o4 + 2][j] * wk[2][j] + xv[o4 + 3][j] * wk[3][j];
            u32x4 o;
            o.x = pk2(silu_f(acc[0]), silu_f(acc[1])); o.y = pk2(silu_f(acc[2]), silu_f(acc[3]));
            o.z = pk2(silu_f(acc[4]), silu_f(acc[5])); o.w = pk2(silu_f(acc[6]), silu_f(acc[7]));
            *(u32x4*)(xc + (size_t)(t0 + o4) * 4096 + c0) = o;
            const int pos = pos0 + o4;
            if (pos >= L - 3) {
                float* d = cso + (size_t)(pos - (L - 3)) * 4096 + c0;
                *(f32x4*)d = (f32x4){xv[o4 + 3][0], xv[o4 + 3][1], xv[o4 + 3][2], xv[o4 + 3][3]};
                *(f32x4*)(d + 4) = (f32x4){xv[o4 + 3][4], xv[o4 + 3][5], xv[o4 + 3][6], xv[o4 + 3][7]};
            }
        }
    };
    if (gtid < nitems) {
        u32x4 rawA[7], rawB[7];
        size_t it = gtid;
        ldrows(it, rawA);
        for (;;) {
            size_t itn = it + gstride;
            ldrows(min(itn, nitems - 1), rawB);
            __builtin_amdgcn_sched_barrier(0);
            compute(it, rawA);
            it = itn; if (it >= nitems) break;
            itn = it + gstride;
            ldrows(min(itn, nitems - 1), rawA);
            __builtin_amdgcn_sched_barrier(0);
            compute(it, rawB);
            it = itn; if (it >= nitems) break;
        }
    }
    for (size_t it = gtid; it < (size_t)T_ALL * 32; it += gstride) {
        const int hh = (int)(it & 31);
        const float x = p.dtraw[it] + p.m_dt_bias[l * 32 + hh];
        const float dt = x > 20.f ? x : __logf(1.f + __expf(x));
        const float A = -__expf(p.m_a_log[l * 32 + hh]);
        p.dtsp[it] = dt;
        p.decay[it] = __expf(dt * A);
    }
}

#define SSD_MS 144u
#define SSD_XS 144u
#define SSD_MT 32768u
#define SSD_XT 41984u
#define SSD_ZT 51200u
#define SSD_AR 60416u
__device__ __forceinline__ unsigned off_b(unsigned row, unsigned ch) { return 256u * row + 16u * (ch ^ (((row & 3u) << 2) | ((row >> 2) & 3u))); }
__device__ __forceinline__ void tr_read8(u32x2 (&d)[8], const unsigned (&a)[8]) {
    asm volatile("ds_read_b64_tr_b16 %0, %8\n\tds_read_b64_tr_b16 %1, %9\n\tds_read_b64_tr_b16 %2, %10\n\tds_read_b64_tr_b16 %3, %11\n\t"
                 "ds_read_b64_tr_b16 %4, %12\n\tds_read_b64_tr_b16 %5, %13\n\tds_read_b64_tr_b16 %6, %14\n\tds_read_b64_tr_b16 %7, %15\n\ts_waitcnt lgkmcnt(0)"
                 : "=&v"(d[0]), "=&v"(d[1]), "=&v"(d[2]), "=&v"(d[3]), "=&v"(d[4]), "=&v"(d[5]), "=&v"(d[6]), "=&v"(d[7])
                 : "v"(a[0]), "v"(a[1]), "v"(a[2]), "v"(a[3]), "v"(a[4]), "v"(a[5]), "v"(a[6]), "v"(a[7]) : "memory");
}
__device__ __forceinline__ void tr_read4(u32x2 (&d)[4], const unsigned (&a)[4]) {
    asm volatile("ds_read_b64_tr_b16 %0, %4\n\tds_read_b64_tr_b16 %1, %5\n\tds_read_b64_tr_b16 %2, %6\n\tds_read_b64_tr_b16 %3, %7\n\ts_waitcnt lgkmcnt(0)"
                 : "=&v"(d[0]), "=&v"(d[1]), "=&v"(d[2]), "=&v"(d[3]) : "v"(a[0]), "v"(a[1]), "v"(a[2]), "v"(a[3]) : "memory");
}
__device__ __forceinline__ bf16x8 frag8(const u32x2& lo, const u32x2& hi) { u32x4 v; v.x = lo.x; v.y = lo.y; v.z = hi.x; v.w = hi.y; return __builtin_bit_cast(bf16x8, v); }

__device__ __forceinline__ void phase_ssd(const Params& p, int l, char* smem) {
    const int tid = TIDX, lane = tid & 63, w = p.wv;
    const int q4 = lane >> 4, c16 = lane & 15;
    const unsigned g = lane >> 4, tq = (lane & 15) >> 2, tp = lane & 3;
    char* Bt = smem; char* Ct = smem + 16384; char* Mt = smem + SSD_MT; char* Xt = smem + SSD_XT; char* Zt = smem + SSD_ZT;
    float* acum = (float*)(smem + SSD_AR); float* dtv = acum + 64; float* wv = acum + 128; float* eA = acum + 192; float* cdec = acum + 256; float* ssql = acum + 260;
    const unsigned lbase = (unsigned)(size_t)smem;
    const bf16_t* xc = p.bufB;
    const int ssd_bid = BIDX, ssd_G = gridDim.x;
    const bool split = ssd_G >= 512;
    const int it_first = split ? (ssd_bid < 256 ? ssd_bid : 256 + (ssd_bid - 256)) : ssd_bid;
    const int it_end = split ? (ssd_bid < 256 ? ssd_bid + 1 : 256 + 1024) : 256 + 1024;
    const int it_step = split ? (ssd_G - 256) : ssd_G;
    for (int item = it_first; item < it_end; item += it_step) {
        int b, hh, nchunks, nvalid, row0; size_t soff; bool has_init;
        if (item < 256) { b = item >> 5; hh = item & 31; nchunks = 32; nvalid = 64; row0 = b * 2048; has_init = false;
                          soff = (size_t)OFF_PR_SSM + (((size_t)l * 8 + b) * 32 + hh) * 8192; }
        else { const int it = item - 256; b = it >> 5; hh = it & 31; nchunks = 1; nvalid = 16; row0 = T_P + b * 16; has_init = true;
               soff = (size_t)OFF_SM_SSM + (((size_t)l * 32 + b) * 32 + hh) * 8192; }
        float* so = p.out + soff;
        const float* si = p.state_ssm + (((size_t)l * 32 + b) * 32 + hh) * 8192;
        const int grp = hh >> 2;
        const float Ah = -__expf(p.m_a_log[l * 32 + hh]), dsk = p.m_d_skip[l * 32 + hh];
        f32x4 sT[8];
#pragma unroll
        for (int nt = 0; nt < 8; ++nt) {
            f32x4 v = (f32x4){0.f, 0.f, 0.f, 0.f};
            if (has_init) v = *(const f32x4*)(si + (size_t)(16 * w + c16) * 128 + 16 * nt + 4 * q4);
            sT[nt] = v;
        }
        __syncthreads();
        u32x4 rB[4], rC[4], rX[2]; float rdt = 0.f;
        auto load_chunk = [&](int c) {
            const int tid = TIDX;
#pragma unroll
            for (int k = 0; k < 4; ++k) {
                const int id = tid + 256 * k, row = id >> 4, ch = id & 15;
                if (row < nvalid) {
                    const bf16_t* src = xc + (size_t)(row0 + c * 64 + row) * 4096 + 2048 + grp * 128 + ch * 8;
                    rB[k] = *(const u32x4*)src; rC[k] = *(const u32x4*)(src + 1024);
                } else { rB[k] = (u32x4){0u, 0u, 0u, 0u}; rC[k] = (u32x4){0u, 0u, 0u, 0u}; }
            }
#pragma unroll
            for (int k = 0; k < 2; ++k) {
                const int id = tid + 256 * k, row = id >> 3, ch = id & 7;
                if (row < nvalid) rX[k] = *(const u32x4*)(xc + (size_t)(row0 + c * 64 + row) * 4096 + hh * 64 + ch * 8);
                else rX[k] = (u32x4){0u, 0u, 0u, 0u};
            }
            if (tid < 64) rdt = (tid < nvalid) ? p.dtsp[(size_t)(row0 + c * 64 + tid) * 32 + hh] : 0.f;
        };
        load_chunk(0);
        for (int c = 0; c < nchunks; ++c) {
#pragma unroll
            for (int k = 0; k < 4; ++k) {
                const unsigned id = tid + 256 * k, row = id >> 4, ch = id & 15;
                *(u32x4*)(Bt + off_b(row, ch)) = rB[k];
                *(u32x4*)(Ct + off_b(row, ch)) = rC[k];
            }
#pragma unroll
            for (int k = 0; k < 2; ++k) {
                const unsigned id = tid + 256 * k, row = id >> 3, ch = id & 7;
                *(u32x4*)(Xt + row * SSD_XS + ch * 16) = rX[k];
            }
            if (w == 0) {
                float v = rdt * Ah;
                v += __int_as_float(__builtin_amdgcn_update_dpp(0, __float_as_int(v), 0x111, 0xf, 0xf, true));
                v += __int_as_float(__builtin_amdgcn_update_dpp(0, __float_as_int(v), 0x112, 0xf, 0xf, true));
                v += __int_as_float(__builtin_amdgcn_update_dpp(0, __float_as_int(v), 0x114, 0xf, 0xf, true));
                v += __int_as_float(__builtin_amdgcn_update_dpp(0, __float_as_int(v), 0x118, 0xf, 0xf, true));
                v += __int_as_float(__builtin_amdgcn_update_dpp(0, __float_as_int(v), 0x142, 0xa, 0xf, false));
                v += __int_as_float(__builtin_amdgcn_update_dpp(0, __float_as_int(v), 0x143, 0xc, 0xf, false));
                const float tot = __int_as_float(__builtin_amdgcn_readlane(__float_as_int(v), 63));
                acum[lane] = v; dtv[lane] = rdt; wv[lane] = rdt * __expf(tot - v); eA[lane] = __expf(v);
                if (lane == 0) cdec[0] = __expf(tot);
            }
            __syncthreads();
            u32x4 rZ[2];
#pragma unroll
            for (int k = 0; k < 2; ++k) {
                const int id = tid + 256 * k, row = id >> 3, ch = id & 7;
                if (row < nvalid) rZ[k] = *(const u32x4*)(p.zbuf + (size_t)(row0 + c * 64 + row) * 2048 + hh * 64 + ch * 8);
                else rZ[k] = (u32x4){0u, 0u, 0u, 0u};
            }
            {
                bf16x8 cf[4];
#pragma unroll
                for (int s4 = 0; s4 < 4; ++s4) cf[s4] = *(const bf16x8*)(Ct + off_b(c16 + 16 * w, 4 * s4 + q4));
                float ai[4];
#pragma unroll
                for (int r = 0; r < 4; ++r) ai[r] = acum[16 * w + 4 * q4 + r];
#pragma unroll
                for (int tj = 0; tj < 4; ++tj) {
                    u32x2 mv; mv.x = 0u; mv.y = 0u;
                    if (tj <= w) {
                        f32x4 cb = (f32x4){0.f, 0.f, 0.f, 0.f};
#pragma unroll
                        for (int s4 = 0; s4 < 4; ++s4) {
                            const bf16x8 bfr = *(const bf16x8*)(Bt + off_b(c16 + 16 * tj, 4 * s4 + q4));
                            cb = __builtin_amdgcn_mfma_f32_16x16x32_bf16(cf[s4], bfr, cb, 0, 0, 0);
                        }
                        const int j = 16 * tj + c16;
                        const float aj = acum[j], dj = dtv[j];
                        float m[4];
#pragma unroll
                        for (int r = 0; r < 4; ++r) { const int i = 16 * w + 4 * q4 + r; m[r] = (j <= i) ? cb[r] * __expf(ai[r] - aj) * dj : 0.f; }
                        mv.x = pk2(m[0], m[1]); mv.y = pk2(m[2], m[3]);
                    }
                    *(u32x2*)(Mt + (16 * tj + c16) * SSD_MS + (16 * w + 4 * q4) * 2) = mv;
                }
            }
            f32x4 yacc[4];
#pragma unroll
            for (int it = 0; it < 4; ++it) yacc[it] = (f32x4){0.f, 0.f, 0.f, 0.f};
#pragma unroll
            for (int kp = 0; kp < 4; ++kp) {
                u32x4 sb;
                sb.x = pk2_sw(sT[2 * kp].x, sT[2 * kp].y); sb.y = pk2_sw(sT[2 * kp].z, sT[2 * kp].w); sb.z = pk2_sw(sT[2 * kp + 1].x, sT[2 * kp + 1].y); sb.w = pk2_sw(sT[2 * kp + 1].z, sT[2 * kp + 1].w);
                const unsigned n0 = 32 * kp + 4 * q4, n1 = n0 + 16;
#pragma unroll
                for (int it = 0; it < 4; ++it) {
                    const unsigned row = 16 * it + c16;
                    const u32x2 lo = *(const u32x2*)(Ct + off_b(row, n0 >> 3) + 8 * ((n0 >> 2) & 1)), hi = *(const u32x2*)(Ct + off_b(row, n1 >> 3) + 8 * ((n1 >> 2) & 1));
                    yacc[it] = __builtin_amdgcn_mfma_f32_16x16x32_bf16(__builtin_bit_cast(bf16x8, sb), frag8(lo, hi), yacc[it], 0, 0, 0);
                }
            }
#pragma unroll
            for (int it = 0; it < 4; ++it) yacc[it] *= eA[16 * it + c16];
#pragma unroll
            for (int k = 0; k < 2; ++k) { const unsigned id = tid + 256 * k, row = id >> 3, ch = id & 7; *(u32x4*)(Zt + row * SSD_XS + ch * 16) = rZ[k]; }
            __syncthreads();
            if (c + 1 < nchunks) load_chunk(c + 1);
            bf16x8 xf[2];
            {
                unsigned ax[4];
#pragma unroll
                for (int ks = 0; ks < 2; ++ks)
#pragma unroll
                    for (int t = 0; t < 2; ++t) ax[ks * 2 + t] = lbase + SSD_XT + (32u * ks + 8u * g + 4u * t + tq) * SSD_XS + (16u * w + 4u * tp) * 2u;
                u32x2 dx[4]; tr_read4(dx, ax);
                xf[0] = frag8(dx[0], dx[1]); xf[1] = frag8(dx[2], dx[3]);
            }
#pragma unroll
            for (int ih = 0; ih < 2; ++ih) {
                unsigned am[8];
#pragma unroll
                for (int ii = 0; ii < 2; ++ii)
#pragma unroll
                    for (int ks = 0; ks < 2; ++ks)
#pragma unroll
                        for (int t = 0; t < 2; ++t) am[(ii * 2 + ks) * 2 + t] = lbase + SSD_MT + (32u * ks + 8u * g + 4u * t + tq) * SSD_MS + (16u * (2 * ih + ii) + 4u * tp) * 2u;
                u32x2 dm[8]; tr_read8(dm, am);
#pragma unroll
                for (int ii = 0; ii < 2; ++ii)
#pragma unroll
                    for (int ks = 0; ks < 2; ++ks)
                        yacc[2 * ih + ii] = __builtin_amdgcn_mfma_f32_16x16x32_bf16(xf[ks], frag8(dm[(ii * 2 + ks) * 2], dm[(ii * 2 + ks) * 2 + 1]), yacc[2 * ih + ii], 0, 0, 0);
            }
#pragma unroll
            for (int it = 0; it < 4; ++it) {
                const int i = 16 * it + c16, pc0 = 16 * w + 4 * q4;
                const u32x2 x4 = *(const u32x2*)(Xt + i * SSD_XS + pc0 * 2), z4 = *(const u32x2*)(Zt + i * SSD_XS + pc0 * 2);
                const float v0 = (yacc[it].x + dsk * bf_lo(x4.x)) * silu_f(bf_lo(z4.x)), v1 = (yacc[it].y + dsk * bf_hi(x4.x)) * silu_f(bf_hi(z4.x));
                const float v2 = (yacc[it].z + dsk * bf_lo(x4.y)) * silu_f(bf_lo(z4.y)), v3 = (yacc[it].w + dsk * bf_hi(x4.y)) * silu_f(bf_hi(z4.y));
                if (i < nvalid) { u32x2 o; o.x = pk2(v0, v1); o.y = pk2(v2, v3); *(u32x2*)(p.bufA + (size_t)(row0 + c * 64 + i) * 2048 + hh * 64 + pc0) = o; }
                const float ssr = xor32_sum(xor16_sum((v0 * v0 + v1 * v1) + (v2 * v2 + v3 * v3)));
                if (q4 == 0) ssql[w * 64 + i] = ssr;
            }
            {
                bf16x8 x2f[2];
#pragma unroll
                for (int ks = 0; ks < 2; ++ks) {
                    const f32x4 w0 = *(const f32x4*)(wv + 32 * ks + 8 * g), w1 = *(const f32x4*)(wv + 32 * ks + 8 * g + 4);
                    const u32x4 u = __builtin_bit_cast(u32x4, xf[ks]);
                    u32x4 o;
                    o.x = pk2(bf_lo(u.x) * w0.x, bf_hi(u.x) * w0.y); o.y = pk2(bf_lo(u.y) * w0.z, bf_hi(u.y) * w0.w);
                    o.z = pk2(bf_lo(u.z) * w1.x, bf_hi(u.z) * w1.y); o.w = pk2(bf_lo(u.w) * w1.z, bf_hi(u.w) * w1.w);
                    x2f[ks] = __builtin_bit_cast(bf16x8, o);
                }
                const float cd = cdec[0];
#pragma unroll
                for (int nq = 0; nq < 4; ++nq) {
                    unsigned ab[8];
#pragma unroll
                    for (int ii = 0; ii < 2; ++ii)
#pragma unroll
                        for (int ks = 0; ks < 2; ++ks)
#pragma unroll
                            for (int t = 0; t < 2; ++t) ab[(ii * 2 + ks) * 2 + t] = lbase + off_b(32u * ks + 8u * g + 4u * t + tq, 2u * (2u * nq + ii) + (tp >> 1)) + 8u * (tp & 1u);
                    u32x2 db[8]; tr_read8(db, ab);
#pragma unroll
                    for (int ii = 0; ii < 2; ++ii) {
                        f32x4 acc = sT[2 * nq + ii] * cd;
#pragma unroll
                        for (int ks = 0; ks < 2; ++ks) acc = __builtin_amdgcn_mfma_f32_16x16x32_bf16(frag8(db[(ii * 2 + ks) * 2], db[(ii * 2 + ks) * 2 + 1]), x2f[ks], acc, 0, 0, 0);
                        sT[2 * nq + ii] = acc;
                    }
                }
            }
            __syncthreads();
            if (tid < 64 && tid < nvalid) p.ssq_y[(size_t)(row0 + c * 64 + tid) * 32 + hh] = (ssql[tid] + ssql[64 + tid]) + (ssql[128 + tid] + ssql[192 + tid]);
        }
#pragma unroll
        for (int nt = 0; nt < 8; ++nt) *(f32x4*)(so + (size_t)(16 * w + c16) * 128 + 16 * nt + 4 * q4) = sT[nt];
    }
    if (split) { if (ssd_bid >= 256) { if (l == 0) { convert_transposes(p, smem, 1, N_TJOBS, ssd_bid - 256, ssd_G - 256); convert_plain(p, (size_t)(ssd_bid - 256) * NTHREADS + tid, (size_t)(ssd_G - 256) * NTHREADS); }
                                       convert_tables(p, 2 * l, 2, (size_t)(ssd_bid - 256) * NTHREADS + tid, (size_t)(ssd_G - 256) * NTHREADS); } }
    else { if (l == 0) { convert_transposes(p, smem, 1, N_TJOBS, ssd_bid, ssd_G); convert_plain(p, (size_t)ssd_bid * NTHREADS + tid, (size_t)ssd_G * NTHREADS); }
           convert_tables(p, 2 * l, 2, (size_t)ssd_bid * NTHREADS + tid, (size_t)ssd_G * NTHREADS); }
}

#define AT_V 24576u
#define AT_VS 144u
__device__ __forceinline__ void phase_attn(const Params& p, int j, char* smem) {
    const int tid = TIDX, lane = tid & 63, w = p.wv, q4 = lane >> 4, c16 = lane & 15;
    const unsigned g = lane >> 4, tq = (lane & 15) >> 2, tp = lane & 3;
    const unsigned lbase = (unsigned)(size_t)smem;
    const bf16_t* qb = p.bufB;
    bf16_t* ob = p.bufB + (size_t)T_ALL * 1024;
    for (int item = BIDX; item < 1024 + 128; item += gridDim.x) {
        const bool prompt = item < 1024;
        int b, c = 0, kvh, qrow0, nqt, klo, khi;
        if (prompt) { b = item >> 7; c = (item >> 2) & 31; kvh = item & 3; qrow0 = b * 2048 + c * 64; nqt = 4; klo = c >= 2 ? 0 : (2 - c) * 64; khi = 192; }
        else { const int s = item - 1024; b = s >> 2; kvh = s & 3; qrow0 = T_P + b * 16; nqt = 1; klo = 0; khi = 144; }
        __syncthreads();
#pragma unroll
        for (int hb = 0; hb < 2; ++hb) {
            f32x4 kq[6], vq[6];
#pragma unroll
            for (int i2 = 0; i2 < 6; ++i2) {
                const int id = tid + 256 * (6 * hb + i2), row = id >> 4, cq = id & 15, rc = min(max(row, klo), khi - 1);
                const float* kp_kv = p.kv + (size_t)(prompt ? b * 2048 + (c - 2) * 64 + rc : T_P + b * 16 + max(rc - 128, 0)) * 512 + kvh * 64;
                const size_t co = ((size_t)(b * 128 + min(rc, 127)) * 4 + kvh) * 64;
                const bool from_cache = !prompt && rc < 128;
                const float* kp = from_cache ? p.cache_k + co : kp_kv;
                const float* vp = from_cache ? p.cache_v + co : kp_kv + 256;
                kq[i2] = *(const f32x4*)(kp + cq * 4); vq[i2] = *(const f32x4*)(vp + cq * 4);
            }
#pragma unroll
            for (int i2 = 0; i2 < 6; ++i2) {
                const int id = tid + 256 * (6 * hb + i2), row = id >> 4, cq = id & 15;
                const bool ok = row >= klo && row < khi;
                const f32x4 z = (f32x4){0.f, 0.f, 0.f, 0.f}, kx = ok ? kq[i2] : z, vx = ok ? vq[i2] : z;
                u32x2 kb, vb; kb.x = pk2(kx.x, kx.y); kb.y = pk2(kx.z, kx.w); vb.x = pk2(vx.x, vx.y); vb.y = pk2(vx.z, vx.w);
                *(u32x2*)(smem + row * 128 + ((((cq >> 1) ^ ((row >> 1) & 7))) << 4) + (cq & 1) * 8) = kb;
                *(u32x2*)(smem + AT_V + row * AT_VS + cq * 8) = vb;
            }
        }
        __syncthreads();
        const int hq = kvh * 4 + w;
        const float sink = p.a_sinks[j * 16 + hq];
        for (int qt = 0; qt < nqt; ++qt) {
            const bf16_t* qp = qb + (size_t)(qrow0 + 16 * qt + c16) * 1024 + hq * 64 + 8 * q4;
            const bf16x8 qf0 = *(const bf16x8*)qp, qf1 = *(const bf16x8*)(qp + 32);
            f32x4 sacc[12];
#pragma unroll
            for (int kt = 0; kt < 12; ++kt) {
                const int r = 16 * kt + c16;
                const bf16x8 kf0 = *(const bf16x8*)(smem + r * 128 + ((q4 ^ ((r >> 1) & 7)) << 4));
                const bf16x8 kf1 = *(const bf16x8*)(smem + r * 128 + (((4 + q4) ^ ((r >> 1) & 7)) << 4));
                f32x4 acc = (f32x4){0.f, 0.f, 0.f, 0.f};
                acc = __builtin_amdgcn_mfma_f32_16x16x32_bf16(kf0, qf0, acc, 0, 0, 0);
                acc = __builtin_amdgcn_mfma_f32_16x16x32_bf16(kf1, qf1, acc, 0, 0, 0);
                sacc[kt] = acc;
            }
            float mx = sink;
#pragma unroll
            for (int kt = 0; kt < 12; ++kt)
#pragma unroll
                for (int r = 0; r < 4; ++r) {
                    const int key = 16 * kt + 4 * q4 + r;
                    const float v = (key >= klo && key < khi) ? sacc[kt][r] * 0.125f : -INFINITY;
                    sacc[kt][r] = v; mx = fmaxf(mx, v);
                }
            mx = xor32_max(xor16_max(mx));
            float lsum = 0.f;
#pragma unroll
            for (int kt = 0; kt < 12; ++kt)
#pragma unroll
                for (int r = 0; r < 4; ++r) { const float pe = __expf(sacc[kt][r] - mx); sacc[kt][r] = pe; lsum += pe; }
            lsum = xor32_sum(xor16_sum(lsum));
            lsum += __expf(sink - mx);
            const float inv = 1.f / lsum;
            bf16x8 pf[6];
#pragma unroll
            for (int kp = 0; kp < 6; ++kp) {
                u32x4 u; u.x = pk2(sacc[2 * kp][0], sacc[2 * kp][1]); u.y = pk2(sacc[2 * kp][2], sacc[2 * kp][3]);
                u.z = pk2(sacc[2 * kp + 1][0], sacc[2 * kp + 1][1]); u.w = pk2(sacc[2 * kp + 1][2], sacc[2 * kp + 1][3]);
                pf[kp] = __builtin_bit_cast(bf16x8, u);
            }
#pragma unroll
            for (int dt = 0; dt < 4; ++dt) {
                unsigned a8[8], a4[4];
#pragma unroll
                for (int kp = 0; kp < 4; ++kp) {
                    a8[2 * kp] = lbase + AT_V + (32u * kp + 4u * g + tq) * AT_VS + (16u * dt + 4u * tp) * 2u;
                    a8[2 * kp + 1] = lbase + AT_V + (32u * kp + 16u + 4u * g + tq) * AT_VS + (16u * dt + 4u * tp) * 2u;
                }
#pragma unroll
                for (int kp = 4; kp < 6; ++kp) {
                    a4[2 * (kp - 4)] = lbase + AT_V + (32u * kp + 4u * g + tq) * AT_VS + (16u * dt + 4u * tp) * 2u;
                    a4[2 * (kp - 4) + 1] = lbase + AT_V + (32u * kp + 16u + 4u * g + tq) * AT_VS + (16u * dt + 4u * tp) * 2u;
                }
                u32x2 d8[8], d4[4]; tr_read8(d8, a8); tr_read4(d4, a4);
                f32x4 oacc = (f32x4){0.f, 0.f, 0.f, 0.f};
#pragma unroll
                for (int kp = 0; kp < 4; ++kp) oacc = __builtin_amdgcn_mfma_f32_16x16x32_bf16(frag8(d8[2 * kp], d8[2 * kp + 1]), pf[kp], oacc, 0, 0, 0);
#pragma unroll
                for (int kp = 4; kp < 6; ++kp) oacc = __builtin_amdgcn_mfma_f32_16x16x32_bf16(frag8(d4[2 * (kp - 4)], d4[2 * (kp - 4) + 1]), pf[kp], oacc, 0, 0, 0);
                u32x2 o; o.x = pk2(oacc.x * inv, oacc.y * inv); o.y = pk2(oacc.z * inv, oacc.w * inv);
                *(u32x2*)(ob + (size_t)(qrow0 + 16 * qt + c16) * 1024 + hq * 64 + 16 * dt + 4 * q4) = o;
            }
        }
    }
}

__device__ __forceinline__ void phase_kvwin(const Params& p) {
    const size_t gtid = (size_t)BIDX * NTHREADS + TIDX, gstride = (size_t)gridDim.x * NTHREADS;
    for (size_t i4 = gtid; i4 < (size_t)8 * 128 * 64; i4 += gstride) {
        const size_t i = i4 * 4; const int b = (int)(i >> 15), r = (int)(i >> 8) & 127, c = (int)(i & 255);
        const float* src = p.kv + (size_t)(b * 2048 + 1920 + r) * 512 + c;
        const f32x4 kk = *(const f32x4*)src, vv = *(const f32x4*)(src + 256);
        *(f32x4*)(p.out + OFF_PR_K + i) = kk; *(f32x4*)(p.out + OFF_PR_V + i) = vv;
    }
    for (size_t i4 = gtid; i4 < (size_t)32 * 128 * 64; i4 += gstride) {
        const size_t i = i4 * 4; const int b = (int)(i >> 15), r = (int)(i >> 8) & 127, c = (int)(i & 255);
        const bool fc = r < 112;
        const size_t co = ((size_t)b * 128 + min(r + 16, 127)) * 256 + c;
        const float* srck = p.kv + (size_t)(T_P + b * 16 + max(r - 112, 0)) * 512 + c;
        const float* kp = fc ? p.cache_k + co : srck;
        const float* vp = fc ? p.cache_v + co : srck + 256;
        const f32x4 kk = *(const f32x4*)kp, vv = *(const f32x4*)vp;
        *(f32x4*)(p.out + OFF_SM_K + i) = kk; *(f32x4*)(p.out + OFF_SM_V + i) = vv;
    }
}

#define TK_CE(a, i, j) { const float hi_ = fmaxf(a[i], a[j]), lo_ = fminf(a[i], a[j]); a[i] = hi_; a[j] = lo_; }
__device__ __forceinline__ void sort16_desc(float (&a)[16]) { TK_CE(a,0,1) TK_CE(a,2,3) TK_CE(a,0,2) TK_CE(a,1,3) TK_CE(a,1,2) TK_CE(a,4,5) TK_CE(a,6,7) TK_CE(a,4,6) TK_CE(a,5,7) TK_CE(a,5,6) TK_CE(a,0,4) TK_CE(a,2,6) TK_CE(a,2,4) TK_CE(a,1,5) TK_CE(a,3,7) TK_CE(a,3,5) TK_CE(a,1,2) TK_CE(a,3,4) TK_CE(a,5,6) TK_CE(a,8,9) TK_CE(a,10,11) TK_CE(a,8,10) TK_CE(a,9,11) TK_CE(a,9,10) TK_CE(a,12,13) TK_CE(a,14,15) TK_CE(a,12,14) TK_CE(a,13,15) TK_CE(a,13,14) TK_CE(a,8,12) TK_CE(a,10,14) TK_CE(a,10,12) TK_CE(a,9,13) TK_CE(a,11,15) TK_CE(a,11,13) TK_CE(a,9,10) TK_CE(a,11,12) TK_CE(a,13,14) TK_CE(a,0,8) TK_CE(a,4,12) TK_CE(a,4,8) TK_CE(a,2,10) TK_CE(a,6,14) TK_CE(a,6,10) TK_CE(a,2,4) TK_CE(a,6,8) TK_CE(a,10,12) TK_CE(a,1,9) TK_CE(a,5,13) TK_CE(a,5,9) TK_CE(a,3,11) TK_CE(a,7,15) TK_CE(a,7,11) TK_CE(a,3,5) TK_CE(a,7,9) TK_CE(a,11,13) TK_CE(a,1,2) TK_CE(a,3,4) TK_CE(a,5,6) TK_CE(a,7,8) TK_CE(a,9,10) TK_CE(a,11,12) TK_CE(a,13,14) }
__device__ __forceinline__ void bitonic16_desc(float (&a)[16]) { TK_CE(a,0,8) TK_CE(a,1,9) TK_CE(a,2,10) TK_CE(a,3,11) TK_CE(a,4,12) TK_CE(a,5,13) TK_CE(a,6,14) TK_CE(a,7,15) TK_CE(a,0,4) TK_CE(a,1,5) TK_CE(a,2,6) TK_CE(a,3,7) TK_CE(a,8,12) TK_CE(a,9,13) TK_CE(a,10,14) TK_CE(a,11,15) TK_CE(a,0,2) TK_CE(a,1,3) TK_CE(a,4,6) TK_CE(a,5,7) TK_CE(a,8,10) TK_CE(a,9,11) TK_CE(a,12,14) TK_CE(a,13,15) TK_CE(a,0,1) TK_CE(a,2,3) TK_CE(a,4,5) TK_CE(a,6,7) TK_CE(a,8,9) TK_CE(a,10,11) TK_CE(a,12,13) TK_CE(a,14,15) }
__device__ __forceinline__ void merge_top16(float (&a)[16], const float (&b)[16]) {
#pragma unroll
    for (int i = 0; i < 16; ++i) a[i] = fmaxf(a[i], b[15 - i]);
    bitonic16_desc(a);
}
__device__ __forceinline__ void ins16(float (&top)[16], float x) {
#pragma unroll
    for (int k = 0; k < 16; ++k) { const float hi = fmaxf(top[k], x); x = fminf(top[k], x); top[k] = hi; }
}
__device__ __forceinline__ void tk_load16(float (&k)[16], const bf16_t* s, int g) {
    const u32x4 a = *(const u32x4*)(s + 16 * g), b = *(const u32x4*)(s + 16 * g + 8);
    const unsigned u[8] = {a.x, a.y, a.z, a.w, b.x, b.y, b.z, b.w};
#pragma unroll
    for (int i = 0; i < 8; ++i) {
        k[2 * i] = __uint_as_float((u[i] << 16) | (unsigned)(16 * g + 2 * i));
        k[2 * i + 1] = __uint_as_float((u[i] & 0xffff0000u) | (unsigned)(16 * g + 2 * i + 1));
    }
}
__device__ __forceinline__ void tk_unpack16(float (&k)[16], const u32x4& a, const u32x4& b, int g) {
    const unsigned u[8] = {a.x, a.y, a.z, a.w, b.x, b.y, b.z, b.w};
#pragma unroll
    for (int i = 0; i < 8; ++i) {
        k[2 * i] = __uint_as_float((u[i] << 16) | (unsigned)(16 * g + 2 * i));
        k[2 * i + 1] = __uint_as_float((u[i] & 0xffff0000u) | (unsigned)(16 * g + 2 * i + 1));
    }
}
__device__ __forceinline__ void tk_top16_of_128(float (&acc)[16], const bf16_t* s) {
    u32x4 raw[16];
#pragma unroll
    for (int i = 0; i < 16; ++i) raw[i] = *(const u32x4*)(s + 8 * i);
    __builtin_amdgcn_sched_barrier(0);
    tk_unpack16(acc, raw[0], raw[1], 0); sort16_desc(acc);
#pragma unroll
    for (int g = 1; g < 8; ++g) { float grp[16]; tk_unpack16(grp, raw[2 * g], raw[2 * g + 1], g); sort16_desc(grp); merge_top16(acc, grp); }
}
__device__ __forceinline__ float tk_cand(const float (&t1)[16], const float (&t2)[16], int i, int j) {
    const float v = __uint_as_float(__float_as_uint(t1[i]) & ~127u) + __uint_as_float(__float_as_uint(t2[j]) & ~127u);
    return __uint_as_float((__float_as_uint(v) & ~255u) | (unsigned)(i * 16 + j));
}
__device__ __forceinline__ void phase_topk(const Params& p, char* smem) {
    const int tid = TIDX;
    const size_t gtid = (size_t)BIDX * NTHREADS + tid, gstride = (size_t)gridDim.x * NTHREADS;
    const bf16_t* sc = (const bf16_t*)p.ybuf;
    unsigned char* myl = (unsigned char*)smem + tid * 36;
    for (size_t row = gtid; row < (size_t)T_ALL * 8; row += gstride) {
        const bf16_t* s = sc + row * 256;
        float t1[16], t2[16];
        tk_top16_of_128(t1, s);
        tk_top16_of_128(t2, s + 128);
#pragma unroll
        for (int q = 0; q < 4; ++q) {
            *(unsigned*)(myl + 4 * q) = (__float_as_uint(t1[4 * q]) & 127u) | ((__float_as_uint(t1[4 * q + 1]) & 127u) << 8) | ((__float_as_uint(t1[4 * q + 2]) & 127u) << 16) | ((__float_as_uint(t1[4 * q + 3]) & 127u) << 24);
            *(unsigned*)(myl + 16 + 4 * q) = (__float_as_uint(t2[4 * q]) & 127u) | ((__float_as_uint(t2[4 * q + 1]) & 127u) << 8) | ((__float_as_uint(t2[4 * q + 2]) & 127u) << 16) | ((__float_as_uint(t2[4 * q + 3]) & 127u) << 24);
        }
        float acc[16], grp[16];
#pragma unroll
        for (int j = 0; j < 16; ++j) acc[j] = tk_cand(t1, t2, 0, j);
        sort16_desc(acc);
        {
            int n = 0;
#pragma unroll
            for (int j = 0; j < 8; ++j) grp[n++] = tk_cand(t1, t2, 1, j);
#pragma unroll
            for (int j = 0; j < 5; ++j) grp[n++] = tk_cand(t1, t2, 2, j);
#pragma unroll
            for (int j = 0; j < 3; ++j) grp[n++] = tk_cand(t1, t2, 3, j);
            sort16_desc(grp); merge_top16(acc, grp);
        }
        {
            int n = 0;
            grp[n++] = tk_cand(t1, t2, 3, 3);
#pragma unroll
            for (int j = 0; j < 3; ++j) grp[n++] = tk_cand(t1, t2, 4, j);
#pragma unroll
            for (int i = 5; i < 8; ++i) { grp[n++] = tk_cand(t1, t2, i, 0); grp[n++] = tk_cand(t1, t2, i, 1); }
#pragma unroll
            for (int i = 8; i < 14; ++i) grp[n++] = tk_cand(t1, t2, i, 0);
            sort16_desc(grp); merge_top16(acc, grp);
        }
        ins16(acc, tk_cand(t1, t2, 14, 0));
        ins16(acc, tk_cand(t1, t2, 15, 0));
        float ex[16], sum = 0.f; int te[16];
        const float v0 = __uint_as_float(__float_as_uint(acc[0]) & ~255u);
#pragma unroll
        for (int k = 0; k < 16; ++k) {
            const unsigned kb = __float_as_uint(acc[k]);
            ex[k] = __expf(__uint_as_float(kb & ~255u) - v0); sum += ex[k];
            te[k] = (int)myl[(kb >> 4) & 15u] * 128 + (int)myl[16 + (kb & 15u)];
        }
        const float inv = 1.f / sum;
        const size_t tt = row >> 3; const int hh = (int)(row & 7);
        int* eo = p.eid + tt * 128 + 2 * hh; float* go = p.gate + tt * 128 + 2 * hh;
#pragma unroll
        for (int kk = 0; kk < 16; ++kk) { eo[(kk & 7) * 16 + (kk >> 3)] = te[kk]; go[(kk & 7) * 16 + (kk >> 3)] = ex[kk] * inv; }
    }
}

__device__ __forceinline__ void peer_load_e(int4 (&ev)[4], const int* eid, int t, int ex) {
    const char* q = (const char*)(eid + (size_t)t * 128);
#pragma unroll
    for (int i = 0; i < 4; ++i) ev[i] = *(const int4*)(q + (unsigned)(ex * 64 + 16 * i));
}
__device__ __forceinline__ void peer_load_r(u32x4 (&r)[16], const int4 (&ev)[4], const unsigned char* tab, unsigned pc) {
#pragma unroll
    for (int i = 0; i < 4; ++i) {
        r[4 * i + 0] = *(const u32x4*)(tab + (size_t)((unsigned)ev[i].x * 128u + pc)); r[4 * i + 1] = *(const u32x4*)(tab + (size_t)((unsigned)ev[i].y * 128u + pc));
        r[4 * i + 2] = *(const u32x4*)(tab + (size_t)((unsigned)ev[i].z * 128u + pc)); r[4 * i + 3] = *(const u32x4*)(tab + (size_t)((unsigned)ev[i].w * 128u + pc));
    }
}

__device__ __forceinline__ void g1_compute(const Params& p, const u32x4 (&r)[16], unsigned xr, int t, int s, int sub, int lane, char* xs) {
    const float x0 = bf_lo(xr), x1 = bf_hi(xr);
    float am = fmaxf(fabsf(x0), fabsf(x1));
    am = fmaxf(am, dpp_mov<0xB1>(am)); am = fmaxf(am, dpp_mov<0x4E>(am)); am = fmaxf(am, dpp_mov<0x141>(am)); am = fmaxf(am, dpp_mov<0x140>(am));
    am = xor32_max(xor16_max(am));
    am = fmaxf(am, 1e-20f);
    const float qs = 127.f / am;
    const int i0 = max(-127, min(127, __float2int_rn(x0 * qs))), i1 = max(-127, min(127, __float2int_rn(x1 * qs)));
    *(unsigned short*)(xs + 2 * lane) = (unsigned short)((i0 & 255) | ((i1 & 255) << 8));
    const u32x4 qv = *(const u32x4*)(xs + 16 * sub);
    const unsigned qx[4] = {qv.x, qv.y, qv.z, qv.w};
    int d[16];
#pragma unroll
    for (int g = 0; g < 16; ++g) {
        int acc = __builtin_amdgcn_sdot4((int)r[g].x, (int)qx[0], 0, false);
        acc = __builtin_amdgcn_sdot4((int)r[g].y, (int)qx[1], acc, false);
        acc = __builtin_amdgcn_sdot4((int)r[g].z, (int)qx[2], acc, false);
        acc = __builtin_amdgcn_sdot4((int)r[g].w, (int)qx[3], acc, false);
        d[g] = acc;
    }
    const bool b2 = (sub & 4) != 0, b1 = (sub & 2) != 0, b0 = (sub & 1) != 0;
    int n8[8], n4[4], n2[2];
#pragma unroll
    for (int i = 0; i < 8; ++i) { const int send = b2 ? d[i] : d[8 + i], keep = b2 ? d[8 + i] : d[i]; n8[i] = keep + dpp_movi<0x141>(send); }
#pragma unroll
    for (int i = 0; i < 4; ++i) { const int send = b1 ? n8[i] : n8[4 + i], keep = b1 ? n8[4 + i] : n8[i]; n4[i] = keep + dpp_movi<0x4E>(send); }
#pragma unroll
    for (int i = 0; i < 2; ++i) { const int send = b0 ? n4[i] : n4[2 + i], keep = b0 ? n4[2 + i] : n4[i]; n2[i] = keep + dpp_movi<0xB1>(send); }
    const float sc = am * (1.f / (127.f * 512.f));
    char* po = (char*)(p.partial + ((size_t)t * 8 + s) * 128);
    *(float*)(po + (unsigned)(4 * lane)) = (float)n2[0] * sc; *(float*)(po + (unsigned)(4 * lane + 256)) = (float)n2[1] * sc;
}
__device__ __forceinline__ void phase_g1(const Params& p, int l, char* smem) {
    const int tid = TIDX, lane = tid & 63, w = __builtin_amdgcn_readfirstlane(tid >> 6), bid = BIDX;
    const int nrank = gridDim.x >> 3;
    if (bid >= nrank * 8) return;
    const int s = bid & 7, rank = bid >> 3, sub = lane & 7, ex = lane >> 3, stride = nrank * 4;
    const unsigned char* ut = p.u8 + ((size_t)l * 8 + s) * 16384 * 128;
    const unsigned pc = 16u * sub;
    const bf16_t* xb = p.xn2 + 128 * s; const unsigned xo = 4u * lane;
    char* xs = smem + 128 * w;
    int t = rank * 4 + w;
    if (t >= T_ALL) return;
    int4 e0[4], e1[4]; u32x4 rA[16], rB[16]; unsigned xA, xB;
    peer_load_e(e0, p.eid, t, ex); peer_load_e(e1, p.eid, min(t + stride, T_ALL - 1), ex);
    peer_load_r(rA, e0, ut, pc);
    xA = *(const unsigned*)((const char*)(xb + (size_t)t * DM) + xo);
    for (;;) {
        {
            const int tn = t + stride, tc = min(tn, T_ALL - 1), tcc = min(tn + stride, T_ALL - 1);
            peer_load_e(e0, p.eid, tcc, ex);
            peer_load_r(rB, e1, ut, pc); xB = *(const unsigned*)((const char*)(xb + (size_t)tc * DM) + xo);
            __builtin_amdgcn_sched_barrier(0);
            g1_compute(p, rA, xA, t, s, sub, lane, xs);
            t = tn; if (t >= T_ALL) break;
        }
        {
            const int tn = t + stride, tc = min(tn, T_ALL - 1), tcc = min(tn + stride, T_ALL - 1);
            peer_load_e(e1, p.eid, tcc, ex);
            peer_load_r(rA, e0, ut, pc); xA = *(const unsigned*)((const char*)(xb + (size_t)tc * DM) + xo);
            __builtin_amdgcn_sched_barrier(0);
            g1_compute(p, rB, xB, t, s, sub, lane, xs);
            t = tn; if (t >= T_ALL) break;
        }
    }
}

__device__ __forceinline__ void phase_w(const Params& p) {
    const int lane = TIDX & 63, gw = BIDX * 4 + p.wv, nw = gridDim.x * 4;
    for (int t0 = gw; t0 < T_ALL; t0 += 2 * nw) {
        float sm[2][2], gt[2][2], sq[2];
        f32x4 qv[2][4]; float pv[2][2][8];
#pragma unroll
        for (int u = 0; u < 2; ++u) {
            const int t = min(t0 + u * nw, T_ALL - 1);
#pragma unroll
            for (int q = 0; q < 4; ++q) qv[u][q] = *(const f32x4*)(p.ssq_h2 + (size_t)t * 16 + q * 4);
#pragma unroll
            for (int j = 0; j < 2; ++j) {
                const int pos = 2 * lane + j, ex = pos >> 4, g = pos & 15, pslot = (g & 1) * 64 + ex * 8 + (g >> 1);
#pragma unroll
                for (int s2 = 0; s2 < 8; ++s2) pv[u][j][s2] = p.partial[((size_t)t * 8 + s2) * 128 + pslot];
                gt[u][j] = p.gate[(size_t)t * 128 + pos];
            }
        }
        __builtin_amdgcn_sched_barrier(0);
#pragma unroll
        for (int u = 0; u < 2; ++u) {
            float q4s = 0.f;
#pragma unroll
            for (int q = 0; q < 4; ++q) q4s += (qv[u][q].x + qv[u][q].y) + (qv[u][q].z + qv[u][q].w);
            sq[u] = q4s;
#pragma unroll
            for (int j = 0; j < 2; ++j) sm[u][j] = ((pv[u][j][0] + pv[u][j][1]) + (pv[u][j][2] + pv[u][j][3])) + ((pv[u][j][4] + pv[u][j][5]) + (pv[u][j][6] + pv[u][j][7]));
        }
#pragma unroll
        for (int u = 0; u < 2; ++u) {
            const int t = t0 + u * nw;
            if (t < T_ALL) {
                const float rr = rsqrtf(sq[u] * (1.f / 1024.f) + 1e-6f);
                const float w0 = gt[u][0] * gelu_tanh(sm[u][0] * rr), w1 = gt[u][1] * gelu_tanh(sm[u][1] * rr);
                float wm = fmaxf(fabsf(w0), fabsf(w1));
                wm = fmaxf(wm, dpp_mov<0xB1>(wm)); wm = fmaxf(wm, dpp_mov<0x4E>(wm)); wm = fmaxf(wm, dpp_mov<0x141>(wm)); wm = fmaxf(wm, dpp_mov<0x140>(wm));
                wm = xor32_max(xor16_max(wm));
                wm = fmaxf(wm, 1e-30f);
                const float qs = 127.f / wm;
                const int q0 = max(-127, min(127, __float2int_rn(w0 * qs))), q1 = max(-127, min(127, __float2int_rn(w1 * qs)));
                *(unsigned short*)(p.wq + (size_t)t * 128 + 2 * lane) = (unsigned short)((q0 & 255) | ((q1 & 255) << 8));
                if (lane == 0) p.wscale[t] = wm * (1.f / (127.f * 256.f));
            }
        }
    }
}

template <class Pre>
__device__ __forceinline__ void g2_compute(const Params& p, const u32x4 (&r)[16], const u32x4& wq, float wsc, const f32x2& hv, int t, int s, int sub, int lane, Pre&& pre) {
    int acc[16];
#pragma unroll
    for (int i = 0; i < 16; ++i) acc[i] = 0;
#pragma unroll
    for (int gq = 0; gq < 4; ++gq) {
        pre(gq);
        __builtin_amdgcn_sched_barrier(0);
        const int wp = (int)wq[gq];
#pragma unroll
        for (int i = 0; i < 4; ++i) {
            const unsigned a = r[4 * gq][i], b = r[4 * gq + 1][i], c = r[4 * gq + 2][i], d = r[4 * gq + 3][i];
            const unsigned ab_lo = __builtin_amdgcn_perm(b, a, 0x05010400u), ab_hi = __builtin_amdgcn_perm(b, a, 0x07030602u);
            const unsigned cd_lo = __builtin_amdgcn_perm(d, c, 0x05010400u), cd_hi = __builtin_amdgcn_perm(d, c, 0x07030602u);
            const unsigned t0 = __builtin_amdgcn_perm(cd_lo, ab_lo, 0x05040100u), t1 = __builtin_amdgcn_perm(cd_lo, ab_lo, 0x07060302u);
            const unsigned t2 = __builtin_amdgcn_perm(cd_hi, ab_hi, 0x05040100u), t3 = __builtin_amdgcn_perm(cd_hi, ab_hi, 0x07060302u);
            acc[4 * i + 0] = __builtin_amdgcn_sdot4((int)t0, wp, acc[4 * i + 0], false);
            acc[4 * i + 1] = __builtin_amdgcn_sdot4((int)t1, wp, acc[4 * i + 1], false);
            acc[4 * i + 2] = __builtin_amdgcn_sdot4((int)t2, wp, acc[4 * i + 2], false);
            acc[4 * i + 3] = __builtin_amdgcn_sdot4((int)t3, wp, acc[4 * i + 3], false);
        }
    }
    const bool b5 = (lane & 32) != 0, b4 = (lane & 16) != 0, b3 = (lane & 8) != 0;
    int n8[8], n4[4], n2[2];
#pragma unroll
    for (int i = 0; i < 8; ++i) { const auto r2 = __builtin_amdgcn_permlane32_swap((unsigned)acc[i], (unsigned)acc[8 + i], false, false); n8[i] = (int)(r2[0] + r2[1]); }
#pragma unroll
    for (int i = 0; i < 4; ++i) { const auto r2 = __builtin_amdgcn_permlane16_swap((unsigned)n8[i], (unsigned)n8[4 + i], false, false); n4[i] = (int)(r2[0] + r2[1]); }
#pragma unroll
    for (int i = 0; i < 2; ++i) { const int send = b3 ? n4[i] : n4[2 + i], keep = b3 ? n4[2 + i] : n4[i]; n2[i] = keep + dpp_movi<0x128>(send); }
    const int src = ((lane & 7) << 5) | ((lane >> 3) << 2);
    const int m0 = __builtin_amdgcn_ds_bpermute(src, n2[0]), m1 = __builtin_amdgcn_ds_bpermute(src, n2[1]);
    const size_t o = (size_t)t * DM + 128 * s;
    const f32x2 ho = hv + (f32x2){(float)m0 * wsc, (float)m1 * wsc};
    *(f32x2*)((char*)(p.h + o) + (unsigned)(8 * lane)) = ho;
    *(unsigned*)((char*)(p.xn + o) + (unsigned)(4 * lane)) = pk2(ho.x, ho.y);
    const float ss = wave_sum(ho.x * ho.x + ho.y * ho.y);
    if (lane == 0) p.ssq_h[(size_t)t * 8 + s] = ss;
}
__device__ __forceinline__ void phase_g2(const Params& p, int l, int mode) {
    const int tid = TIDX, lane = tid & 63, w = __builtin_amdgcn_readfirstlane(tid >> 6), bid = BIDX;
    const int nrank = gridDim.x >> 3;
    if (bid >= nrank * 8) return;
    const int s = bid & 7, rank = bid >> 3, sub = lane & 7, ex = lane >> 3, stride = nrank * 4;
    const unsigned char* vt = p.v8 + ((size_t)l * 8 + s) * 16384 * 128;
    const unsigned pc = 16u * sub;
    const float* hb = p.h2 + 128 * s; const unsigned ho8 = 8u * lane;
    const unsigned char* wb = p.wq; const unsigned wo = 16u * ex;
    int t = rank * 4 + w;
    if (t >= T_ALL) return;
    int4 e0[4], e1[4]; u32x4 rA[16], rB[16], wA, wB; f32x2 hA, hB; float sA, sB;
    peer_load_e(e0, p.eid, t, ex); peer_load_e(e1, p.eid, min(t + stride, T_ALL - 1), ex);
    if (mode != 1) peer_load_r(rA, e0, vt, pc);
    wA = *(const u32x4*)(wb + (size_t)t * 128 + wo); sA = p.wscale[t]; hA = *(const f32x2*)((const char*)(hb + (size_t)t * DM) + ho8);
    for (;;) {
        {
            const int tn = t + stride, tc = min(tn, T_ALL - 1), tcc = min(tn + stride, T_ALL - 1);
            peer_load_e(e0, p.eid, tcc, ex);
            wB = *(const u32x4*)(wb + (size_t)tc * 128 + wo); sB = p.wscale[tc]; hB = *(const f32x2*)((const char*)(hb + (size_t)tc * DM) + ho8);
            __builtin_amdgcn_sched_barrier(0);
            if (mode != 2) g2_compute(p, rA, wA, sA, hA, t, s, sub, lane, [&](int gq) {
                rB[4 * gq + 0] = *(const u32x4*)(vt + (size_t)((unsigned)e1[gq].x * 128u + pc)); rB[4 * gq + 1] = *(const u32x4*)(vt + (size_t)((unsigned)e1[gq].y * 128u + pc));
                rB[4 * gq + 2] = *(const u32x4*)(vt + (size_t)((unsigned)e1[gq].z * 128u + pc)); rB[4 * gq + 3] = *(const u32x4*)(vt + (size_t)((unsigned)e1[gq].w * 128u + pc)); }); else { unsigned x = 0; _Pragma("unroll") for (int i = 0; i < 16; ++i) x |= rA[i].x | rA[i].y | rA[i].z | rA[i].w; asm volatile("" :: "v"(x), "v"(wA), "v"(sA), "v"(hA)); }
            t = tn; if (t >= T_ALL) break;
        }
        {
            const int tn = t + stride, tc = min(tn, T_ALL - 1), tcc = min(tn + stride, T_ALL - 1);
            peer_load_e(e1, p.eid, tcc, ex);
            wA = *(const u32x4*)(wb + (size_t)tc * 128 + wo); sA = p.wscale[tc]; hA = *(const f32x2*)((const char*)(hb + (size_t)tc * DM) + ho8);
            __builtin_amdgcn_sched_barrier(0);
            if (mode != 2) g2_compute(p, rB, wB, sB, hB, t, s, sub, lane, [&](int gq) {
                rA[4 * gq + 0] = *(const u32x4*)(vt + (size_t)((unsigned)e0[gq].x * 128u + pc)); rA[4 * gq + 1] = *(const u32x4*)(vt + (size_t)((unsigned)e0[gq].y * 128u + pc));
                rA[4 * gq + 2] = *(const u32x4*)(vt + (size_t)((unsigned)e0[gq].z * 128u + pc)); rA[4 * gq + 3] = *(const u32x4*)(vt + (size_t)((unsigned)e0[gq].w * 128u + pc)); }); else { unsigned x = 0; _Pragma("unroll") for (int i = 0; i < 16; ++i) x |= rB[i].x | rB[i].y | rB[i].z | rB[i].w; asm volatile("" :: "v"(x), "v"(wB), "v"(sB), "v"(hB)); }
            t = tn; if (t >= T_ALL) break;
        }
    }
}

__device__ __forceinline__ void phase_final(const Params& p) {
    const int lane = TIDX & 63, gw = BIDX * 4 + p.wv, nw = gridDim.x * 4;
    f32x4 gv[4];
#pragma unroll
    for (int i = 0; i < 4; ++i) gv[i] = *(const f32x4*)(p.norm_final + i * 256 + lane * 4);
    for (int row0 = gw; row0 < T_ALL; row0 += 2 * nw) {
        f32x4 v[2][4];
#pragma unroll
        for (int u = 0; u < 2; ++u)
#pragma unroll
            for (int i = 0; i < 4; ++i) v[u][i] = *(const f32x4*)(p.h + (size_t)min(row0 + u * nw, T_ALL - 1) * DM + i * 256 + lane * 4);
#pragma unroll
        for (int u = 0; u < 2; ++u) {
            const int row = row0 + u * nw;
            float ss = 0.f;
#pragma unroll
            for (int i = 0; i < 4; ++i) ss += v[u][i].x * v[u][i].x + v[u][i].y * v[u][i].y + v[u][i].z * v[u][i].z + v[u][i].w * v[u][i].w;
            ss = wave_sum(ss);
            const float inv = rsqrtf(ss * (1.f / 1024.f) + 1e-6f);
            if (row < T_ALL) {
#pragma unroll
                for (int i = 0; i < 4; ++i) *(f32x4*)(p.out + OFF_Y + (size_t)row * DM + i * 256 + lane * 4) = v[u][i] * inv * gv[i];
            }
        }
    }
}

#define XB_TMO      128
#define XB_XCNT(j)  (256  + 64 * (j))
#define XB_XSUB(j)  (1280 + 64 * (j))
#define XB_XGEN(j)  (2304 + 64 * (j))
#define XB_TOP      3328
#define XB_TOPGEN   3392
#define XCD_BAR_WORDS 3456
#define XB_SPIN_CAP (1u << 20)
__device__ __forceinline__ unsigned xb_ld(unsigned* p)              { return __hip_atomic_load(p, __ATOMIC_RELAXED, __HIP_MEMORY_SCOPE_AGENT); }
__device__ __forceinline__ unsigned xb_add(unsigned* p, unsigned v) { return __hip_atomic_fetch_add(p, v, __ATOMIC_RELAXED, __HIP_MEMORY_SCOPE_AGENT); }
__device__ __forceinline__ unsigned xb_xcc_id() { return (unsigned)__builtin_amdgcn_s_getreg((3 << 11) | 20) & 0xFu; }
#define XB_SPIN(cond, bar) do { unsigned _sp = 0; while (cond) { __builtin_amdgcn_s_sleep(1); \
    if ((++_sp & 255u) == 0u) { if (xb_ld(&(bar)[XB_TMO])) break; if (_sp > XB_SPIN_CAP) { atomicAdd(&(bar)[XB_TMO], 1u); break; } } } } while (0)
struct XcdBarrier { unsigned* bar; unsigned x; volatile LAS unsigned* st; int wv; };
__device__ __forceinline__ XcdBarrier xcd_barrier_post(unsigned* bar, volatile LAS unsigned* st, int wv) {
    XcdBarrier b; b.bar = bar; b.x = xb_xcc_id(); b.st = st; b.wv = wv;
    if (lt(wv) == 0) (void)xb_add(&bar[XB_XCNT(b.x)], 1u);
    return b;
}
__device__ __forceinline__ void xcd_barrier_complete(unsigned* bar, unsigned x, unsigned& nloc, unsigned& nx) {
    const unsigned G = gridDim.x * gridDim.y * gridDim.z;
    unsigned sum, cnt, mine, sp = 0u;
    for (;;) {
        sum = 0u; cnt = 0u; mine = 0u;
#pragma unroll
        for (unsigned j = 0; j < 16; ++j) { const unsigned c = xb_ld(&bar[XB_XCNT(j)]); sum += c; cnt += (c > 0u) ? 1u : 0u; mine = (j == x) ? c : mine; }
        if (sum == G) break;
        __builtin_amdgcn_s_sleep(1);
        if ((++sp & 255u) == 0u) { if (xb_ld(&bar[XB_TMO])) break; if (sp > XB_SPIN_CAP) { atomicAdd(&bar[XB_TMO], 1u); break; } }
    }
    nloc = mine > 0u ? mine : 1u; nx = cnt > 0u ? cnt : 1u;
}
__device__ __forceinline__ void xcd_barrier(const XcdBarrier& b) {
    asm volatile("s_waitcnt vmcnt(0)" ::: "memory");
    __syncthreads();
    if (lt(b.wv) == 0) {
        unsigned* bar = b.bar;
        __builtin_amdgcn_s_waitcnt(0);
        unsigned nloc = b.st[0], nx = b.st[1];
        if (nloc == 0u) { xcd_barrier_complete(bar, b.x, nloc, nx); b.st[0] = nloc; b.st[1] = nx; }
        const unsigned old = xb_add(&bar[XB_XSUB(b.x)], 1u);
        const unsigned gen = old / nloc;
        if (old + 1u == (gen + 1u) * nloc) {
            __builtin_amdgcn_fence(__ATOMIC_RELEASE, "agent");
            asm volatile("s_waitcnt vmcnt(0)" ::: "memory");
            const unsigned og = xb_add(&bar[XB_TOP], 1u);
            const unsigned tg = og / nx;
            if (og + 1u == (tg + 1u) * nx) xb_add(&bar[XB_TOPGEN], 1u);
            else XB_SPIN(xb_ld(&bar[XB_TOPGEN]) == tg, bar);
            __builtin_amdgcn_fence(__ATOMIC_ACQUIRE, "agent");
            xb_add(&bar[XB_XGEN(b.x)], 1u);
            asm volatile("s_waitcnt vmcnt(0)" ::: "memory");
        } else {
            XB_SPIN(xb_ld(&bar[XB_XGEN(b.x)]) == gen, bar);
            __builtin_amdgcn_fence(__ATOMIC_ACQUIRE, "agent");
            asm volatile("s_waitcnt vmcnt(0)" ::: "memory");
        }
    }
    __syncthreads();
}

#define N_PHASES 37

__device__ __forceinline__ void phase_wfuse(const Params& p, char* smem) {
    const RowScale rs{nullptr, 0, 0.f};
    for (int id = BIDX; id < 512; id += gridDim.x) {
        const int l = id >> 7, hh = (id >> 3) & 15, mt = id & 7;
        EpiTransBf16 e{p.w_pq_t + ((size_t)l * 2048 + hh * 128) * 1024, 1024};
        gemm_tile<4>(p.wq_b + (size_t)l * 1024 * 2048 + hh * 128, 2048, p.subk + ((size_t)l * 2 + (hh & 1)) * 16384, 128, 128, mt * 128, 0, smem, e, rs, p.wv);
    }
}

#ifndef PROBE_G2_MODE
#define PROBE_G2_MODE 0
#endif
__device__ __forceinline__ void run_peer_phase(const Params& p, int l, int sub, char* smem, bool probe) {
    if (sub == 0) { EpiBf16<false> e{(bf16_t*)p.ybuf, 2048, nullptr}; RowScale rs{p.ssq_h2, 16, 1.f / 1024.f}; gemm_phase<6>(p.xn2, DM, p.w_pq_t + (size_t)l * 2048 * 1024, DM, 1024, T_ALL, 2048, smem, e, rs, p.wv); }
    else if (sub == 1) phase_topk(p, smem);
    else if (sub == 2) phase_g1(p, l, smem);
    else if (sub == 3) phase_w(p);
    else phase_g2(p, l, probe ? PROBE_G2_MODE : 0);
}

__device__ __forceinline__ void run_phase(const Params& p, int ph, char* smem, bool probe = false) {
    if (ph == 0) { phase_convert(p, smem); phase_embed(p); return; }
    if (ph == 1) return;
    if (ph == N_PHASES - 1) { phase_final(p); return; }
    const RowScale rs_h{p.ssq_h, 8, 1.f / 1024.f}, rs_none{nullptr, 0, 0.f};
    if (ph < 20) {
        const int l = (ph - 2) / 9, sub = (ph - 2) % 9;
        if (sub == 0) { EpiInProj e{p.zbuf, p.bufA, p.dtraw}; gemm_phase<6>(p.xn, DM, p.w_in_t + (size_t)l * 6272 * 1024, DM, 1024, T_ALL, 6272, smem, e, rs_h, p.wv); }
        else if (sub == 1) phase_conv(p, l);
        else if (sub == 2) phase_ssd(p, l, smem);
        else if (sub == 3) { EpiResidual<false> e{p.h, p.h2, p.xn2, p.ssq_h2, nullptr}; RowScale rs{p.ssq_y, 32, 1.f / 2048.f};
                             gemm_phase<3>(p.bufA, 2048, p.w_out_t + (size_t)l * 1024 * 2048, 2048, 2048, T_ALL, 1024, smem, e, rs, p.wv);
                             if (l == 0) phase_wfuse(p, smem); }
        else run_peer_phase(p, l, sub - 4, smem, probe);
        return;
    }
    const int j = (ph - 20) / 8, sub = (ph - 20) % 8, l = 2 + j;
    if (sub == 0) {
        { EpiBf16<true> e{p.bufB, 1024, p.a_b_q + (size_t)j * 1024}; gemm_phase<3>(p.xn, DM, p.w_aq_t + (size_t)j * 1024 * 1024, DM, 1024, T_ALL, 1024, smem, e, rs_h, p.wv); }
        if (j == 0) { EpiF32<true> e{p.kv, 512, 0, p.a_b_kv}; gemm_phase<3>(p.xn, DM, p.w_kv_t, DM, 1024, T_ALL, 512, smem, e, rs_h, p.wv); }
    }
    else if (sub == 1) { phase_attn(p, j, smem); if (j == 0) phase_kvwin(p); }
    else if (sub == 2) { EpiResidual<true> e{p.h, p.h2, p.xn2, p.ssq_h2, p.a_b_o + (size_t)j * 1024};
                         gemm_phase<3>(p.bufB + (size_t)T_ALL * 1024, 1024, p.w_ao_t + (size_t)j * 1024 * 1024, 1024, 1024, T_ALL, 1024, smem, e, rs_none, p.wv); }
    else run_peer_phase(p, l, sub - 3, smem, probe);
}

#ifndef PROBE_MASK
#define PROBE_MASK 0
#endif
__device__ __forceinline__ int phase_kind(int ph) {
    if (ph == 0) return 0;
    if (ph == 1) return 14;
    if (ph == N_PHASES - 1) return 13;
    if (ph < 20) return 1 + (ph - 2) % 9;
    const int sub = (ph - 20) % 8;
    return sub < 3 ? 10 + sub : 5 + (sub - 3);
}
__global__ void __launch_bounds__(NTHREADS, 2) mega(Params pk) {
    Params p = pk; p.wv = __builtin_amdgcn_readfirstlane((int)(threadIdx.x >> 6));
    extern __shared__ __attribute__((aligned(16))) char smem[];
    volatile LAS unsigned* st = (volatile LAS unsigned*)(smem + DYN_LDS_BYTES - 16);
    if (lt(p.wv) == 0) { st[0] = 0u; st[1] = 0u; }
    __syncthreads();
    XcdBarrier xb = xcd_barrier_post(p.bar, st, p.wv);
    for (int ph = p.ph_lo; ph < p.ph_hi; ++ph) {
#if PROBE_MASK
        if ((PROBE_MASK >> phase_kind(ph)) & 1) { run_phase(p, ph, smem, true); xcd_barrier(xb); }
#endif
        if (ph == 1) continue;
        run_phase(p, ph, smem);
        if (ph + 1 < p.ph_hi) {
            xcd_barrier(xb);
        }
    }
}

extern "C" void kernel_launch(void* const* d_in, const int* in_sizes, int n_in, void* d_out, int out_size, void* d_ws, size_t ws_size, hipStream_t stream) {
    Params p{};
    const float* const* in = (const float* const*)d_in;
    p.x_prompt = in[0]; p.x_sample = in[1]; p.state_ssm = in[2]; p.state_conv = in[3]; p.cache_k = in[4]; p.cache_v = in[5];
    p.norm_mix = in[6]; p.norm_ffn = in[7]; p.norm_kv = in[8]; p.norm_final = in[9];
    p.m_w_in = in[10]; p.m_conv_w = in[11]; p.m_conv_b = in[12]; p.m_dt_bias = in[13]; p.m_a_log = in[14]; p.m_d_skip = in[15]; p.m_norm = in[16]; p.m_w_out = in[17];
    p.a_w_kv = in[18]; p.a_b_kv = in[19]; p.a_w_q = in[20]; p.a_b_q = in[21]; p.a_sinks = in[22]; p.a_w_o = in[23]; p.a_b_o = in[24];
    p.p_w_q = in[25]; p.p_sub_k1 = in[26]; p.p_sub_k2 = in[27]; p.p_u = in[28]; p.p_v = in[29];
    p.out = (float*)d_out;
    char* w = (char*)d_ws; size_t off = 0;
    auto take = [&](size_t bytes) { char* r = w + off; off += (bytes + 255) & ~(size_t)255; return r; };
    p.bar = (unsigned*)take(65536);
    p.w_in_t = (bf16_t*)take((size_t)2 * 6272 * 1024 * 2);
    p.w_out_t = (bf16_t*)take((size_t)2 * 1024 * 2048 * 2);
    p.w_kv_t = (bf16_t*)take((size_t)512 * 1024 * 2);
    p.w_aq_t = (bf16_t*)take((size_t)2 * 1024 * 1024 * 2);
    p.w_ao_t = (bf16_t*)take((size_t)2 * 1024 * 1024 * 2);
    p.w_pq_t = (bf16_t*)take((size_t)4 * 2048 * 1024 * 2);
    p.wq_b = (bf16_t*)take((size_t)4 * 1024 * 2048 * 2);
    p.subk = (bf16_t*)take((size_t)4 * 2 * 16384 * 2);
    p.u8 = (unsigned char*)take((size_t)4 * 16384 * 1024);
    p.v8 = (unsigned char*)take((size_t)4 * 16384 * 1024);
    p.h = (float*)take((size_t)T_ALL * 1024 * 4);
    p.h2 = (float*)take((size_t)T_ALL * 1024 * 4);
    p.xn = (bf16_t*)take((size_t)T_ALL * 1024 * 2);
    p.xn2 = (bf16_t*)take((size_t)T_ALL * 1024 * 2);
    p.bufA = (bf16_t*)take((size_t)T_ALL * 4096 * 2);
    p.bufB = (bf16_t*)take((size_t)T_ALL * 4096 * 2);
    p.zbuf = (bf16_t*)take((size_t)T_ALL * 2048 * 2);
    p.dtraw = (float*)take((size_t)T_ALL * 32 * 4);
    p.dtsp = (float*)take((size_t)T_ALL * 32 * 4);
    p.decay = (float*)take((size_t)T_ALL * 32 * 4);
    p.ybuf = (float*)take((size_t)T_ALL * 2048 * 4);
    p.eid = (int*)take((size_t)T_ALL * 128 * 4);
    p.gate = (float*)take((size_t)T_ALL * 128 * 4);
    p.wq = (unsigned char*)take((size_t)T_ALL * 128);
    p.wscale = (float*)take((size_t)T_ALL * 4);
    p.ssq_h = (float*)take((size_t)T_ALL * 8 * 4);
    p.ssq_h2 = (float*)take((size_t)T_ALL * 16 * 4);
    p.ssq_y = (float*)take((size_t)T_ALL * 64 * 4);
    p.partial = (float*)p.bufB;
    p.kv = (float*)(p.bufB + (size_t)T_ALL * 2048);
    if (off > ws_size) { fprintf(stderr, "kernel_launch: workspace too small: need %zu have %zu\n", off, ws_size); return; }
    static int grid = 0;
    if (grid == 0) {
        int dev = 0, cus = 0, per_cu = 0;
        (void)hipGetDevice(&dev);
        (void)hipDeviceGetAttribute(&cus, hipDeviceAttributeMultiprocessorCount, dev);
        (void)hipFuncSetAttribute((const void*)mega, hipFuncAttributeMaxDynamicSharedMemorySize, DYN_LDS_BYTES);
        (void)hipOccupancyMaxActiveBlocksPerMultiprocessor(&per_cu, (const void*)mega, NTHREADS, DYN_LDS_BYTES);
        if (per_cu > 2) per_cu = 2;
        if (per_cu < 1) per_cu = 1;
        grid = cus * per_cu;
    }
    (void)hipMemsetAsync(p.bar, 0, XCD_BAR_WORDS * 4, stream);
    p.ph_lo = 0; p.ph_hi = N_PHASES;
    void* args[] = {&p};
    hipError_t e = hipLaunchCooperativeKernel((const void*)mega, dim3(grid), dim3(NTHREADS), args, DYN_LDS_BYTES, stream);
    if (e != hipSuccess) fprintf(stderr, "cooperative launch failed: %s (grid %d)\n", hipGetErrorString(e), grid);
}
```
